# Optimizing an MI355X kernel written in HIP

```python
import math
import jax, jax.numpy as jnp
from jax import lax
import numpy as np

D_MODEL = 1024
BATCH = 16
SEQ = 2048
DEPTH = 2

CHUNK = 64
Q_BLOCK = 128
EPS = 1e-6
NEG = -1e30
CONV_WIDTH = 256
CONV_K = 3
SSM_WIDTH = 256
SSM_GROUP = 16
SSM_GROUPS = SSM_WIDTH // SSM_GROUP
SSM_STATE = 64
ATTN_HEADS = 8
HEAD_DIM = 64
IDX_HEADS = 4
IDX_DIM = 64
TOPK_MAX = 256
D_FF = -(-(8 * D_MODEL) // (3 * 256)) * 256
N_BRANCHES = 3
D_IN = (3 * CONV_WIDTH + SSM_WIDTH + ATTN_HEADS * HEAD_DIM + 2 * HEAD_DIM
        + IDX_HEADS * IDX_DIM + IDX_DIM + IDX_HEADS + N_BRANCHES * D_MODEL)

kernel_name = "chunk_causal_hybrid_conv_s5_dsa_adaln"


def _in_split_points():
    sizes = (3 * CONV_WIDTH, SSM_WIDTH, ATTN_HEADS * HEAD_DIM, HEAD_DIM, HEAD_DIM,
             IDX_HEADS * IDX_DIM, IDX_DIM, IDX_HEADS)
    return tuple(int(v) for v in np.cumsum(sizes))


def rms_norm(x, gain):
    xf = x.astype(jnp.float32)
    y = xf * lax.rsqrt(jnp.mean(xf * xf, axis=-1, keepdims=True) + EPS)
    return (y * gain.astype(jnp.float32)).astype(x.dtype)


def modulate(h, shift, scale):
    return h * (1.0 + scale[:, None, :]) + shift[:, None, :]


def short_conv_branch(xin, conv_w, w_out):
    b_g, c_g, val = jnp.split(xin, 3, axis=-1)
    z = c_g * val
    s = z.shape[1]
    zp = jnp.pad(z, ((0, 0), (CONV_K - 1, 0), (0, 0)))
    y = sum(conv_w[k] * zp[:, k:k + s] for k in range(CONV_K))
    return (b_g * y) @ w_out


def _ssm_combine(e1, e2):
    a1r, a1i, b1r, b1i = e1
    a2r, a2i, b2r, b2i = e2
    return (a2r * a1r - a2i * a1i,
            a2r * a1i + a2i * a1r,
            a2r * b1r - a2i * b1i + b2r,
            a2r * b1i + a2i * b1r + b2i)


def s5_branch(u, a_re, a_im, log_dt, b_re, b_im, c_re, c_im, d_skip, w_glu):
    dtype = u.dtype
    bsz, s, _ = u.shape
    f32 = jnp.float32
    uf = u.astype(f32).reshape(bsz, s, SSM_GROUPS, SSM_GROUP)
    ar, ai = a_re.astype(f32), a_im.astype(f32)
    dt = jnp.exp(log_dt.astype(f32))[:, None]
    mag = jnp.exp(dt * ar)
    abar_re = mag * jnp.cos(dt * ai)
    abar_im = mag * jnp.sin(dt * ai)
    den = ar * ar + ai * ai
    nr, ni = abar_re - 1.0, abar_im
    coef_re = (nr * ar + ni * ai) / den
    coef_im = (ni * ar - nr * ai) / den
    br, bi = b_re.astype(f32), b_im.astype(f32)
    bb_re = coef_re[..., None] * br - coef_im[..., None] * bi
    bb_im = coef_re[..., None] * bi + coef_im[..., None] * br
    v_re = jnp.einsum('bsgj,gpj->bsgp', uf, bb_re)
    v_im = jnp.einsum('bsgj,gpj->bsgp', uf, bb_im)
    a_r = jnp.broadcast_to(abar_re, v_re.shape)
    a_i = jnp.broadcast_to(abar_im, v_re.shape)
    _, _, h_re, h_im = lax.associative_scan(_ssm_combine, (a_r, a_i, v_re, v_im), axis=1)
    y = (jnp.einsum('bsgp,gjp->bsgj', h_re, c_re.astype(f32))
         - jnp.einsum('bsgp,gjp->bsgj', h_im, c_im.astype(f32))
         + d_skip.astype(f32).reshape(SSM_GROUPS, SSM_GROUP) * uf)
    z = jax.nn.gelu(y.reshape(bsz, s, SSM_WIDTH)).astype(dtype)
    za, zb = jnp.split(z @ w_glu, 2, axis=-1)
    return za * jax.nn.sigmoid(zb)


def dsa_branch(q, k, v, qi, ki, wi, w_out):
    f32 = jnp.float32
    bsz, s, _ = q.shape
    q = q.reshape(bsz, s, ATTN_HEADS, HEAD_DIM)
    qi = qi.reshape(bsz, s, IDX_HEADS, IDX_DIM)
    k_sel = min(TOPK_MAX, s // 4)
    n_blocks = s // Q_BLOCK
    slopes = 2.0 ** (-(jnp.arange(1, ATTN_HEADS + 1, dtype=f32) * (8.0 / ATTN_HEADS)))
    key_pos = jnp.arange(s, dtype=jnp.int32)
    gather = jax.vmap(lambda tb, ib: tb[ib])

    def block(i):
        start = i * Q_BLOCK
        qb = lax.dynamic_slice_in_dim(q, start, Q_BLOCK, axis=1)
        qib = lax.dynamic_slice_in_dim(qi, start, Q_BLOCK, axis=1)
        wib = lax.dynamic_slice_in_dim(wi, start, Q_BLOCK, axis=1)
        t = start + jnp.arange(Q_BLOCK, dtype=jnp.int32)
        sc = jnp.einsum('bthd,bsd->bths', qib, ki).astype(f32) * (IDX_DIM ** -0.5)
        idx_score = jnp.einsum('bth,bths->bts', wib.astype(f32) * (IDX_HEADS ** -0.5), jax.nn.relu(sc))
        admissible = (key_pos[None, :] // CHUNK) <= (t[:, None] // CHUNK)
        idx_score = jnp.where(admissible[None], idx_score, NEG)
        _, sel = lax.top_k(idx_score, k_sel)
        k_g = gather(k, sel)
        v_g = gather(v, sel)
        valid = (sel // CHUNK) <= (t[None, :, None] // CHUNK)
        dist = jnp.abs(t[None, :, None] - sel).astype(f32)
        logits = (jnp.einsum('bthd,btkd->bthk', qb, k_g).astype(f32) * (HEAD_DIM ** -0.5)
                  - slopes[None, None, :, None] * dist[:, :, None, :])
        logits = jnp.where(valid[:, :, None, :], logits, NEG)
        p = jax.nn.softmax(logits, axis=-1).astype(v.dtype)
        return jnp.einsum('bthk,btkd->bthd', p, v_g)

    out = lax.map(block, jnp.arange(n_blocks))
    out = out.transpose(1, 0, 2, 3, 4).reshape(bsz, s, ATTN_HEADS * HEAD_DIM)
    return out @ w_out


def setup_inputs(seed: int = 0) -> dict:
    key = jax.random.key(seed)
    ks = jax.random.split(key, 32)
    f32 = jnp.float32

    def nrm(k, shape, scale):
        return jax.random.normal(k, shape, f32) * scale

    L, D = DEPTH, D_MODEL
    G, P, J = SSM_GROUPS, SSM_STATE, SSM_GROUP
    n_idx = jnp.arange(P, dtype=f32)
    return {
        "x": nrm(ks[0], (BATCH, SEQ, D), 1.0),
        "c": nrm(ks[1], (BATCH, D), 1.0),
        "w_mod": nrm(ks[2], (L, D, 6 * D), 0.5 * D ** -0.5),
        "b_mod": nrm(ks[3], (L, 6 * D), 0.01),
        "norm1": 1.0 + nrm(ks[4], (L, D), 0.01),
        "w_in": nrm(ks[5], (L, D, D_IN), D ** -0.5),
        "b_gate": nrm(ks[6], (L, N_BRANCHES * D), 0.01),
        "conv_w": nrm(ks[7], (L, CONV_K, CONV_WIDTH), CONV_K ** -0.5),
        "w_conv_out": nrm(ks[8], (L, CONV_WIDTH, D), CONV_WIDTH ** -0.5),
        "ssm_a_re": -0.5 + nrm(ks[9], (L, G, P), 0.01),
        "ssm_a_im": math.pi * n_idx + nrm(ks[10], (L, G, P), 0.01),
        "ssm_log_dt": jax.random.uniform(ks[11], (L, G), f32, math.log(0.001), math.log(0.1)),
        "ssm_b_re": nrm(ks[12], (L, G, P, J), (2 * J) ** -0.5),
        "ssm_b_im": nrm(ks[13], (L, G, P, J), (2 * J) ** -0.5),
        "ssm_c_re": nrm(ks[14], (L, G, J, P), (2 * P) ** -0.5),
        "ssm_c_im": nrm(ks[15], (L, G, J, P), (2 * P) ** -0.5),
        "ssm_d": 1.0 + nrm(ks[16], (L, SSM_WIDTH), 0.1),
        "w_glu": nrm(ks[17], (L, SSM_WIDTH, 2 * D), SSM_WIDTH ** -0.5),
        "w_attn_out": nrm(ks[18], (L, ATTN_HEADS * HEAD_DIM, D), (ATTN_HEADS * HEAD_DIM) ** -0.5),
        "w_o": nrm(ks[19], (L, D, D), D ** -0.5),
        "norm2": 1.0 + nrm(ks[20], (L, D), 0.01),
        "w_ffn_in": nrm(ks[21], (L, D, 2 * D_FF), D ** -0.5),
        "w_ffn_out": nrm(ks[22], (L, D_FF, D), D_FF ** -0.5),
        "norm_f": 1.0 + nrm(ks[23], (D,), 0.01),
    }


def reference(x, c, w_mod, b_mod, norm1, w_in, b_gate, conv_w, w_conv_out,
              ssm_a_re, ssm_a_im, ssm_log_dt, ssm_b_re, ssm_b_im, ssm_c_re, ssm_c_im,
              ssm_d, w_glu, w_attn_out, w_o, norm2, w_ffn_in, w_ffn_out, norm_f):
    split_points = _in_split_points()
    c_act = jax.nn.silu(c)
    for l in range(DEPTH):
        mod = c_act @ w_mod[l] + b_mod[l]
        sh1, sc1, g1, sh2, sc2, g2 = jnp.split(mod, 6, axis=-1)
        h = modulate(rms_norm(x, norm1[l]), sh1, sc1)
        proj = h @ w_in[l]
        p_conv, p_ssm, p_q, p_k, p_v, p_qi, p_ki, p_wi, p_gate = jnp.split(proj, split_points, axis=-1)
        y_a = short_conv_branch(p_conv, conv_w[l], w_conv_out[l])
        y_b = s5_branch(p_ssm, ssm_a_re[l], ssm_a_im[l], ssm_log_dt[l], ssm_b_re[l], ssm_b_im[l],
                        ssm_c_re[l], ssm_c_im[l], ssm_d[l], w_glu[l])
        y_c = dsa_branch(p_q, p_k, p_v, p_qi, p_ki, p_wi, w_attn_out[l])
        g_a, g_b, g_c = jnp.split(jax.nn.sigmoid(p_gate + b_gate[l]), N_BRANCHES, axis=-1)
        mixed = (g_a * y_a + g_b * y_b + g_c * y_c) @ w_o[l]
        x = x + g1[:, None, :] * mixed
        h = modulate(rms_norm(x, norm2[l]), sh2, sc2)
        f_gate, f_up = jnp.split(h @ w_ffn_in[l], 2, axis=-1)
        x = x + g2[:, None, :] * ((jax.nn.silu(f_gate) * f_up) @ w_ffn_out[l])
    return rms_norm(x, norm_f)
```

```cpp
#include <hip/hip_runtime.h>
#include <stdint.h>
#include <math.h>

namespace {
constexpr int D = 1024, NB = 16, S = 2048, M = NB * S, NL = 2;
constexpr int DIN = 5060, PC = 5120, DFF = 2816;
constexpr int PC_CONV = 0, PC_SSM = 768, PC_Q = 1024, PC_K = 1536, PC_V = 1600, PC_KI = 1664, PC_WI = 1728, PC_QI = 1792, PC_G = 2048;

constexpr size_t MiB = 1u << 20;
constexpr size_t WS_MOD = 1 * MiB;
constexpr size_t WS_H = 2 * MiB;
constexpr size_t WS_CONVA = WS_H;
constexpr size_t WS_Z = WS_H + 16 * MiB;
constexpr size_t WS_AO = WS_H + 32 * MiB;
constexpr size_t WS_P = 66 * MiB;
constexpr size_t WS_END = 386 * MiB;

typedef unsigned short bf16_t;
__device__ __forceinline__ float bf2f(bf16_t v) { return __uint_as_float((unsigned)v << 16); }
__device__ __forceinline__ bf16_t f2bf(float f) { unsigned u = __float_as_uint(f); return (bf16_t)((u + 0x7fffu + ((u >> 16) & 1u)) >> 16); }
__device__ __forceinline__ float sigmoidf_(float x) { return 1.f / (1.f + __expf(-x)); }
__device__ __forceinline__ float siluf_(float x) { return x / (1.f + __expf(-x)); }
__device__ __forceinline__ float gelu_tanh(float x) { const float u = 0.7978845608028654f * (x + 0.044715f * x * x * x); return 0.5f * x * (1.f + tanhf(u)); }

__device__ __forceinline__ int refcol_of(int c) {
    if (c < PC_KI) return c;
    if (c < PC_WI) return 1920 + (c - PC_KI);
    if (c < PC_WI + 4) return 1984 + (c - PC_WI);
    if (c < PC_QI) return -1;
    if (c < PC_G) return 1664 + (c - PC_QI);
    return 1988 + (c - PC_G);
}

__global__ void __launch_bounds__(256) k_mod(const float* c, const float* w_mod, const float* b_mod, float* mod) {
    __shared__ float sc[D];
    const int b = blockIdx.y, l = blockIdx.z, n = blockIdx.x * 256 + threadIdx.x;
    for (int k = threadIdx.x; k < D; k += 256) sc[k] = siluf_(c[b * D + k]);
    __syncthreads();
    const float* w = w_mod + (size_t)l * D * 6 * D + n;
    float acc = b_mod[l * 6 * D + n];
    for (int k = 0; k < D; ++k) acc += sc[k] * w[(size_t)k * 6 * D];
    mod[((size_t)l * NB + b) * 6 * D + n] = acc;
}

__global__ void __launch_bounds__(256) k_norm_mod(const float* x, const float* gain, const float* modl, int sh_off, int sc_off, bf16_t* H) {
    __shared__ float red[4];
    const int t = blockIdx.x, b = t / S, tid = threadIdx.x;
    const float4 v = ((const float4*)(x + (size_t)t * D))[tid];
    float s = v.x * v.x + v.y * v.y + v.z * v.z + v.w * v.w;
    for (int o = 32; o > 0; o >>= 1) s += __shfl_xor(s, o);
    if ((tid & 63) == 0) red[tid >> 6] = s;
    __syncthreads();
    const float tot = red[0] + red[1] + red[2] + red[3];
    const float rstd = rsqrtf(tot * (1.f / D) + 1e-6f);
    const float* mb = modl + (size_t)b * 6 * D;
    const float vv[4] = {v.x, v.y, v.z, v.w};
    bf16_t o[4];
    for (int i = 0; i < 4; ++i) { const int k = tid * 4 + i; o[i] = f2bf(vv[i] * rstd * gain[k] * (1.f + mb[sc_off + k]) + mb[sh_off + k]); }
    ushort4 w; w.x = o[0]; w.y = o[1]; w.z = o[2]; w.w = o[3];
    ((ushort4*)(H + (size_t)t * D))[tid] = w;
}
__global__ void __launch_bounds__(256) k_final_norm(float* x, const float* gain) {
    __shared__ float red[4];
    const int t = blockIdx.x, tid = threadIdx.x;
    float4 v = ((const float4*)(x + (size_t)t * D))[tid];
    float s = v.x * v.x + v.y * v.y + v.z * v.z + v.w * v.w;
    for (int o = 32; o > 0; o >>= 1) s += __shfl_xor(s, o);
    if ((tid & 63) == 0) red[tid >> 6] = s;
    __syncthreads();
    const float rstd = rsqrtf((red[0] + red[1] + red[2] + red[3]) * (1.f / D) + 1e-6f);
    const float4 g = ((const float4*)gain)[tid];
    v.x *= rstd * g.x; v.y *= rstd * g.y; v.z *= rstd * g.z; v.w *= rstd * g.w;
    ((float4*)(x + (size_t)t * D))[tid] = v;
}

struct IdMap { int off; __device__ int operator()(int c) const { return c + off; } };
struct PMap { __device__ int operator()(int c) const { return refcol_of(c); } };
template <class CM>
__device__ __forceinline__ void ngemm_tile(float (&acc)[4][4], const bf16_t* A, int lda, int row0, const float* W, int ldw, int col0, CM cm, int K, float (*sA)[68], float (*sB)[68]) {
    const int tid = threadIdx.x, ty = tid >> 4, tx = tid & 15;
    const int ar = tid >> 2, ak = (tid & 3) * 4;
    const int bk = tid >> 4, bc = (tid & 15) * 4;
    int wc[4];
    for (int i = 0; i < 4; ++i) wc[i] = cm(col0 + bc + i);
    for (int k0 = 0; k0 < K; k0 += 16) {
        const ushort4 av = *(const ushort4*)(A + (size_t)(row0 + ar) * lda + k0 + ak);
        sA[ak + 0][ar] = bf2f(av.x); sA[ak + 1][ar] = bf2f(av.y); sA[ak + 2][ar] = bf2f(av.z); sA[ak + 3][ar] = bf2f(av.w);
        for (int i = 0; i < 4; ++i) sB[bk][bc + i] = wc[i] >= 0 ? W[(size_t)(k0 + bk) * ldw + wc[i]] : 0.f;
        __syncthreads();
#pragma unroll
        for (int kk = 0; kk < 16; ++kk) {
            float a[4], b[4];
            for (int i = 0; i < 4; ++i) { a[i] = sA[kk][ty * 4 + i]; b[i] = sB[kk][tx * 4 + i]; }
            for (int i = 0; i < 4; ++i) for (int j = 0; j < 4; ++j) acc[i][j] += a[i] * b[j];
        }
        __syncthreads();
    }
}
#define NG_DECL __shared__ float sA[16][68]; __shared__ float sB[16][68]; const int row0 = blockIdx.y * 64, col0 = blockIdx.x * 64, ty = threadIdx.x >> 4, tx = threadIdx.x & 15;
#define ZERO_ACC(a) for (int i = 0; i < 4; ++i) for (int j = 0; j < 4; ++j) a[i][j] = 0.f;

__global__ void __launch_bounds__(256) k_inproj(const bf16_t* H, const float* w_in, const float* b_gate, bf16_t* P) {
    NG_DECL; float acc[4][4]; ZERO_ACC(acc);
    ngemm_tile(acc, H, D, row0, w_in, DIN, col0, PMap{}, D, sA, sB);
    for (int i = 0; i < 4; ++i) for (int j = 0; j < 4; ++j) { const int r = row0 + ty * 4 + i, c = col0 + tx * 4 + j; float v = acc[i][j];
        if (c >= PC_G) v = sigmoidf_(v + b_gate[c - PC_G]);
        P[(size_t)r * PC + c] = f2bf(v); }
}
__global__ void __launch_bounds__(256) k_mix(const bf16_t* CONVA, const bf16_t* Z, const bf16_t* AO, const float* w_conv_out, const float* w_glu, const float* w_attn_out, bf16_t* P) {
    NG_DECL; float aa[4][4], b1[4][4], b2[4][4], ac[4][4]; ZERO_ACC(aa); ZERO_ACC(b1); ZERO_ACC(b2); ZERO_ACC(ac);
    ngemm_tile(aa, CONVA, 256, row0, w_conv_out, D, col0, IdMap{0}, 256, sA, sB);
    ngemm_tile(b1, Z, 256, row0, w_glu, 2 * D, col0, IdMap{0}, 256, sA, sB);
    ngemm_tile(b2, Z, 256, row0, w_glu, 2 * D, col0, IdMap{D}, 256, sA, sB);
    ngemm_tile(ac, AO, 512, row0, w_attn_out, D, col0, IdMap{0}, 512, sA, sB);
    for (int i = 0; i < 4; ++i) for (int j = 0; j < 4; ++j) { const int r = row0 + ty * 4 + i, c = col0 + tx * 4 + j; bf16_t* pr = P + (size_t)r * PC;
        const float ga = bf2f(pr[PC_G + c]), gb = bf2f(pr[PC_G + D + c]), gc = bf2f(pr[PC_G + 2 * D + c]);
        pr[c] = f2bf(ga * aa[i][j] + gb * b1[i][j] * sigmoidf_(b2[i][j]) + gc * ac[i][j]); }
}
__global__ void __launch_bounds__(256) k_res_gemm(const bf16_t* A, int lda, int K, const float* W, const float* modl, int g_off, const float* Xin, float* Xout) {
    NG_DECL; float acc[4][4]; ZERO_ACC(acc);
    ngemm_tile(acc, A, lda, row0, W, D, col0, IdMap{0}, K, sA, sB);
    for (int i = 0; i < 4; ++i) for (int j = 0; j < 4; ++j) { const int r = row0 + ty * 4 + i, c = col0 + tx * 4 + j, b = r / S;
        Xout[(size_t)r * D + c] = Xin[(size_t)r * D + c] + modl[(size_t)b * 6 * D + g_off + c] * acc[i][j]; }
}
__global__ void __launch_bounds__(256) k_ffn_in(const bf16_t* H, const float* w_ffn_in, bf16_t* ACT) {
    NG_DECL; float ag[4][4], au[4][4]; ZERO_ACC(ag); ZERO_ACC(au);
    ngemm_tile(ag, H, D, row0, w_ffn_in, 2 * DFF, col0, IdMap{0}, D, sA, sB);
    ngemm_tile(au, H, D, row0, w_ffn_in, 2 * DFF, col0, IdMap{DFF}, D, sA, sB);
    for (int i = 0; i < 4; ++i) for (int j = 0; j < 4; ++j) { const int r = row0 + ty * 4 + i, c = col0 + tx * 4 + j;
        ACT[(size_t)r * DFF + c] = f2bf(siluf_(ag[i][j]) * au[i][j]); }
}

__global__ void __launch_bounds__(256) k_conv(const bf16_t* P, const float* conv_w, bf16_t* CONVA) {
    const int t = blockIdx.x, j = threadIdx.x, tl = t % S;
    float y = 0.f;
    for (int k = 0; k < 3; ++k) { const int dt = k - 2; if (tl + dt < 0) continue; const bf16_t* pr = P + (size_t)(t + dt) * PC;
        y += conv_w[k * 256 + j] * bf2f(pr[256 + j]) * bf2f(pr[512 + j]); }
    CONVA[(size_t)t * 256 + j] = f2bf(bf2f(P[(size_t)t * PC + j]) * y);
}

__global__ void __launch_bounds__(64) k_ssm(const bf16_t* P, const float* a_re, const float* a_im, const float* log_dt, const float* b_re, const float* b_im,
                                             const float* c_re, const float* c_im, const float* d_skip, bf16_t* Z) {
    __shared__ float sCr[16][65], sCi[16][65], sH[16][130], sU[16][16];
    const int b = blockIdx.x >> 4, g = blockIdx.x & 15, p = threadIdx.x;
    const double dt = exp((double)log_dt[g]), ar = a_re[g * 64 + p], ai = a_im[g * 64 + p];
    const double mag = exp(dt * ar), abr = mag * cos(dt * ai), abi = mag * sin(dt * ai);
    const double den = ar * ar + ai * ai, nr = abr - 1.0, ni = abi;
    const double cr = (nr * ar + ni * ai) / den, ci = (ni * ar - nr * ai) / den;
    float bbr[16], bbi[16];
#pragma unroll
    for (int j = 0; j < 16; ++j) { const double br = b_re[(g * 64 + p) * 16 + j], bi = b_im[(g * 64 + p) * 16 + j]; bbr[j] = (float)(cr * br - ci * bi); bbi[j] = (float)(cr * bi + ci * br); }
    const float Ar = (float)abr, Ai = (float)abi;
    for (int j = 0; j < 16; ++j) { sCr[j][p] = c_re[(g * 16 + j) * 64 + p]; sCi[j][p] = c_im[(g * 16 + j) * 64 + p]; }
    float hr = 0.f, hi = 0.f;
    const int oj = p & 15, os = p >> 4;
    const float dsk = d_skip[g * 16 + oj];
    for (int t0 = 0; t0 < S; t0 += 16) {
        __syncthreads();
        for (int e = p; e < 256; e += 64) { const int s = e >> 4, j = e & 15; sU[s][j] = bf2f(P[(size_t)(b * S + t0 + s) * PC + PC_SSM + g * 16 + j]); }
        __syncthreads();
        for (int s = 0; s < 16; ++s) {
            float vr = 0.f, vi = 0.f;
#pragma unroll
            for (int j = 0; j < 16; ++j) { const float u = sU[s][j]; vr += u * bbr[j]; vi += u * bbi[j]; }
            const float nr_ = Ar * hr - Ai * hi + vr, ni_ = Ar * hi + Ai * hr + vi; hr = nr_; hi = ni_;
            sH[s][p] = hr; sH[s][65 + p] = hi;
        }
        __syncthreads();
        for (int q = 0; q < 4; ++q) { const int s = os * 4 + q; float y = 0.f;
            for (int pp = 0; pp < 64; ++pp) y += sH[s][pp] * sCr[oj][pp] - sH[s][65 + pp] * sCi[oj][pp];
            y += dsk * sU[s][oj];
            Z[(size_t)(b * S + t0 + s) * 256 + g * 16 + oj] = f2bf(gelu_tanh(y)); }
    }
}

__device__ __forceinline__ float wave_max(float v) { for (int o = 32; o > 0; o >>= 1) v = fmaxf(v, __shfl_xor(v, o)); return v; }
__device__ __forceinline__ float wave_sum(float v) { for (int o = 32; o > 0; o >>= 1) v += __shfl_xor(v, o); return v; }
__device__ __forceinline__ unsigned sortable(float f) { const unsigned b = __float_as_uint(f); return (b & 0x80000000u) ? ~b : (b | 0x80000000u); }
__global__ void __launch_bounds__(64) k_attn(const bf16_t* P, bf16_t* AO) {
    __shared__ float sQI[256], sQ[512], sL[256];
    __shared__ unsigned sU[2048];
    __shared__ int sIdx[256];
    const int t = blockIdx.x, b = t / S, tl = t % S, c = tl >> 6, n = 64 * (c + 1), lane = threadIdx.x;
    const bf16_t* pr = P + (size_t)t * PC;
    for (int e = lane; e < 256; e += 64) sQI[e] = bf2f(pr[PC_QI + e]);
    for (int e = lane; e < 512; e += 64) sQ[e] = bf2f(pr[PC_Q + e]);
    float wi[4]; for (int h = 0; h < 4; ++h) wi[h] = bf2f(pr[PC_WI + h]);
    __syncthreads();
    const bf16_t* Pb = P + (size_t)b * S * PC;
    int nsel;
    if (n <= 256) { for (int k = lane; k < n; k += 64) sIdx[k] = k; nsel = n; }
    else {
        for (int k = lane; k < n; k += 64) {
            const bf16_t* kp = Pb + (size_t)k * PC + PC_KI;
            float dot[4] = {0.f, 0.f, 0.f, 0.f};
#pragma unroll 1
            for (int d0 = 0; d0 < 64; d0 += 8) {
                const uint4 raw = *(const uint4*)(kp + d0);
                const unsigned rw[4] = {raw.x, raw.y, raw.z, raw.w};
#pragma unroll
                for (int i = 0; i < 4; ++i) { const float lo = __uint_as_float(rw[i] << 16), hi = __uint_as_float(rw[i] & 0xffff0000u);
#pragma unroll
                    for (int h = 0; h < 4; ++h) dot[h] += sQI[h * 64 + d0 + 2 * i] * lo + sQI[h * 64 + d0 + 2 * i + 1] * hi; }
            }
            float s = 0.f;
#pragma unroll
            for (int h = 0; h < 4; ++h) s += wi[h] * fmaxf(dot[h], 0.f);
            sU[k] = sortable(s);
        }
        __syncthreads();
        unsigned prefix = 0u;
        for (int bit = 31; bit >= 0; --bit) { const unsigned cand = prefix | (1u << bit); int cnt = 0;
            for (int k = lane; k < n; k += 64) cnt += (sU[k] >= cand) ? 1 : 0;
            cnt = (int)wave_sum((float)cnt);
            if (cnt >= 256) prefix = cand; }
        const unsigned thr = prefix; int cg = 0;
        for (int k = lane; k < n; k += 64) cg += (sU[k] > thr) ? 1 : 0;
        cg = (int)wave_sum((float)cg);
        const int need = 256 - cg; int run_eq = 0, run_sel = 0;
        for (int k0 = 0; k0 < n; k0 += 64) { const unsigned u = sU[k0 + lane]; const bool eq = (u == thr), gt = (u > thr);
            const unsigned long long meq = __ballot(eq); const unsigned long long lt = (1ull << lane) - 1ull;
            const int rank_eq = run_eq + __popcll(meq & lt); const bool sel = gt || (eq && rank_eq < need);
            const unsigned long long msel = __ballot(sel); const int pos = run_sel + __popcll(msel & lt);
            if (sel) sIdx[pos] = k0 + lane;
            run_eq += __popcll(meq); run_sel += __popcll(msel); }
        nsel = 256;
    }
    __syncthreads();
    for (int h = 0; h < 8; ++h) {
        const float slope = exp2f(-(float)(h + 1));
        float lg[4]; float mx = -3.0e38f;
#pragma unroll
        for (int r = 0; r < 4; ++r) { const int j = lane + 64 * r; lg[r] = -3.0e38f;
            if (j < nsel) { const int key = sIdx[j]; const bf16_t* kp = Pb + (size_t)key * PC + PC_K; float dot = 0.f;
#pragma unroll 1
                for (int d0 = 0; d0 < 64; d0 += 8) {
                    const uint4 raw = *(const uint4*)(kp + d0);
                    const unsigned rw[4] = {raw.x, raw.y, raw.z, raw.w};
#pragma unroll
                    for (int i = 0; i < 4; ++i) dot += sQ[h * 64 + d0 + 2 * i] * __uint_as_float(rw[i] << 16) + sQ[h * 64 + d0 + 2 * i + 1] * __uint_as_float(rw[i] & 0xffff0000u);
                }
                lg[r] = dot * 0.125f - slope * fabsf((float)(tl - key)); mx = fmaxf(mx, lg[r]); } }
        mx = wave_max(mx); float sum = 0.f;
#pragma unroll
        for (int r = 0; r < 4; ++r) { const int j = lane + 64 * r; float pv = 0.f; if (j < nsel) pv = __expf(lg[r] - mx); sum += pv; sL[j] = pv; }
        sum = wave_sum(sum);
        __syncthreads();
        float o = 0.f;
        for (int j = 0; j < nsel; ++j) o += sL[j] * bf2f(Pb[(size_t)sIdx[j] * PC + PC_V + lane]);
        AO[(size_t)t * 512 + h * 64 + lane] = f2bf(o / sum);
        __syncthreads();
    }
}
}

extern "C" void kernel_launch(void* const* d_in, const int* in_sizes, int n_in, void* d_out, int out_size, void* d_ws, size_t ws_size, hipStream_t stream) {
    if (n_in != 24 || ws_size < WS_END) return;
    const float* x = (const float*)d_in[0]; const float* c = (const float*)d_in[1];
    const float* w_mod = (const float*)d_in[2]; const float* b_mod = (const float*)d_in[3]; const float* norm1 = (const float*)d_in[4];
    const float* w_in = (const float*)d_in[5]; const float* b_gate = (const float*)d_in[6]; const float* conv_w = (const float*)d_in[7];
    const float* w_conv_out = (const float*)d_in[8]; const float* a_re = (const float*)d_in[9]; const float* a_im = (const float*)d_in[10];
    const float* log_dt = (const float*)d_in[11]; const float* b_re = (const float*)d_in[12]; const float* b_im = (const float*)d_in[13];
    const float* c_re = (const float*)d_in[14]; const float* c_im = (const float*)d_in[15]; const float* ssm_d = (const float*)d_in[16];
    const float* w_glu = (const float*)d_in[17]; const float* w_attn_out = (const float*)d_in[18]; const float* w_o = (const float*)d_in[19];
    const float* norm2 = (const float*)d_in[20]; const float* w_ffn_in = (const float*)d_in[21]; const float* w_ffn_out = (const float*)d_in[22];
    const float* norm_f = (const float*)d_in[23];
    unsigned char* ws = (unsigned char*)d_ws; float* X = (float*)d_out;
    float* MOD = (float*)(ws + WS_MOD); bf16_t* H = (bf16_t*)(ws + WS_H); bf16_t* CONVA = (bf16_t*)(ws + WS_CONVA); bf16_t* Z = (bf16_t*)(ws + WS_Z);
    bf16_t* AO = (bf16_t*)(ws + WS_AO); bf16_t* P = (bf16_t*)(ws + WS_P); bf16_t* ACT = P;

    hipLaunchKernelGGL(k_mod, dim3(6 * D / 256, NB, NL), dim3(256), 0, stream, c, w_mod, b_mod, MOD);
    for (int l = 0; l < NL; ++l) {
        const float* modl = MOD + (size_t)l * NB * 6 * D;
        const float* xin = (l == 0) ? x : X;
        hipLaunchKernelGGL(k_norm_mod, dim3(M), dim3(256), 0, stream, xin, norm1 + l * D, modl, 0, D, H);
        hipLaunchKernelGGL(k_inproj, dim3(PC / 64, M / 64), dim3(256), 0, stream, H, w_in + (size_t)l * D * DIN, b_gate + l * 3 * D, P);
        hipLaunchKernelGGL(k_conv, dim3(M), dim3(256), 0, stream, P, conv_w + l * 3 * 256, CONVA);
        hipLaunchKernelGGL(k_ssm, dim3(NB * 16), dim3(64), 0, stream, P, a_re + l * 1024, a_im + l * 1024, log_dt + l * 16, b_re + l * 16384, b_im + l * 16384,
                           c_re + l * 16384, c_im + l * 16384, ssm_d + l * 256, Z);
        hipLaunchKernelGGL(k_attn, dim3(M), dim3(64), 0, stream, P, AO);
        hipLaunchKernelGGL(k_mix, dim3(D / 64, M / 64), dim3(256), 0, stream, CONVA, Z, AO, w_conv_out + (size_t)l * 256 * D, w_glu + (size_t)l * 256 * 2 * D,
                           w_attn_out + (size_t)l * 512 * D, P);
        hipLaunchKernelGGL(k_res_gemm, dim3(D / 64, M / 64), dim3(256), 0, stream, P, PC, D, w_o + (size_t)l * D * D, modl, 2 * D, xin, X);
        hipLaunchKernelGGL(k_norm_mod, dim3(M), dim3(256), 0, stream, X, norm2 + l * D, modl, 3 * D, 4 * D, H);
        hipLaunchKernelGGL(k_ffn_in, dim3(DFF / 64, M / 64), dim3(256), 0, stream, H, w_ffn_in + (size_t)l * D * 2 * DFF, ACT);
        hipLaunchKernelGGL(k_res_gemm, dim3(D / 64, M / 64), dim3(256), 0, stream, ACT, DFF, DFF, w_ffn_out + (size_t)l * DFF * D, modl, 5 * D, X, X);
    }
    hipLaunchKernelGGL(k_final_norm, dim3(M), dim3(256), 0, stream, X, norm_f);
}
```

```cpp
#include <hip/hip_runtime.h>
#include <stdint.h>
#include <math.h>
#include <stdio.h>

namespace {
constexpr int D = 1024, NB = 16, S = 2048, M = NB * S, NL = 2;
constexpr int DIN = 5060, PC = 5120, DFF = 2816;
constexpr int PC_CONV = 0, PC_SSM = 768, PC_Q = 1024, PC_K = 1536, PC_V = 1600, PC_KI = 1664, PC_WI = 1728, PC_QI = 1792, PC_G = 2048;

constexpr size_t MiB = 1u << 20;
constexpr size_t WS_CTL = 0, CTL_ZERO_BYTES = 64 * 1024;
constexpr size_t WS_CACT = 64 * 1024;
constexpr size_t WS_SSMP = 256 * 1024;
constexpr int SSMP_LAYER = 2048 + 32768;
constexpr size_t WS_MOD = 1 * MiB;
constexpr size_t WS_H = 2 * MiB;
constexpr size_t WS_CONVA = WS_H;
constexpr size_t WS_Z = WS_H + 16 * MiB;
constexpr size_t WS_AO = WS_H + 32 * MiB;
constexpr size_t WS_P = 66 * MiB;
constexpr size_t WS_W = 386 * MiB, WS_W_LAYER = 32 * MiB;
constexpr size_t WO_WIN = 0, WO_WFI = 10 * MiB, WO_WFO = 21 * MiB, WO_WO = 26 * MiB + 512 * 1024, WO_WC = 28 * MiB + 512 * 1024, WO_WGLU = 29 * MiB, WO_WAO = 30 * MiB;
constexpr size_t WS_AP = 450 * MiB;
constexpr size_t WS_KD = 452 * MiB;
constexpr size_t WS_SSMT = 454 * MiB, SSMT_LAYER = 10 * MiB;
constexpr int SSM_NFRAG = 65 + 256 + 256;
constexpr size_t WS_BIAS = 475 * MiB;
constexpr int BIAS_LAYER = NB * PC + NB * 2 * DFF;
constexpr size_t WS_WMODT = 477 * MiB;
constexpr size_t WS_A16 = 501 * MiB;
constexpr size_t WS_SSQ = 504 * MiB;
constexpr size_t WS_END = 506 * MiB;
static_assert(WS_AP + (size_t)NL * 1024 * 65 * 8 <= WS_KD && WS_KD + (size_t)NL * 16 * 64 * 256 * 4 <= WS_SSMT, "ws map");

#define GAS __attribute__((address_space(1)))
#define LAS __attribute__((address_space(3)))
typedef unsigned short bf16_t;
typedef float f32x2v __attribute__((ext_vector_type(2))); typedef float f32x4v __attribute__((ext_vector_type(4))); typedef unsigned u32x2v __attribute__((ext_vector_type(2))); typedef unsigned short u16x4v __attribute__((ext_vector_type(4)));
typedef GAS const float* gcf32; typedef GAS float* gf32; typedef GAS const bf16_t* gcb16; typedef GAS bf16_t* gb16; typedef GAS const unsigned char* gcu8; typedef GAS unsigned char* gu8;
__device__ __forceinline__ float bf2f(bf16_t v) { return __uint_as_float((unsigned)v << 16); }
__device__ __forceinline__ bf16_t f2bf(float f) { unsigned u = __float_as_uint(f); return (bf16_t)((u + 0x7fffu + ((u >> 16) & 1u)) >> 16); }
__device__ __forceinline__ float siluf_(float x) { return x / (1.f + __expf(-x)); }
__device__ __forceinline__ float gelu_tanh(float x) { const float u = 0.7978845608028654f * (x + 0.044715f * x * x * x); return 0.5f * x * (1.f + tanhf(u)); }
__device__ __forceinline__ int refcol_of(int c) {
    if (c < PC_KI) return c;
    if (c < PC_WI) return 1920 + (c - PC_KI);
    if (c < PC_WI + 4) return 1984 + (c - PC_WI);
    if (c < PC_QI) return -1;
    if (c < PC_G) return 1664 + (c - PC_QI);
    return 1988 + (c - PC_G);
}
constexpr int NWAVES = 8, NTHREADS = 512, GRID = 256, NGW = GRID * NWAVES;
constexpr int LDS_BYTES = 147456, MISC_OFF = 145408;
}
__device__ __forceinline__ int lane_id_here() { int l; asm volatile("v_mbcnt_lo_u32_b32 %0, -1, 0\n\tv_mbcnt_hi_u32_b32 %0, -1, %0" : "=v"(l)); return l; }
namespace pg8 {
#define PG8_LAS __attribute__((address_space(3)))
typedef unsigned short bf16_t;
typedef short bf16x8 __attribute__((ext_vector_type(8)));
typedef float f32x4 __attribute__((ext_vector_type(4)));
typedef unsigned u32x4 __attribute__((ext_vector_type(4)));
constexpr int BM = 256, BK = 64, HALF = 128, HTB = HALF * BK * 2  , STAGE_BYTES = 8 * HTB, NXCD = 8, WGM = 8;

__host__ __device__ __forceinline__ int lds_byte(int r, int c) { const int st = (r >> 4) * 2 + (c >> 5), rr = r & 15, cc = c & 31, ob = rr * 64 + cc * 2; return st * 1024 + (ob ^ (((ob >> 9) & 1) << 5)); }
__host__ __device__ __forceinline__ void stage_rc(int b, int& R, int& C) { const int st = b / 1024, sb = b % 1024, swz = sb ^ (((sb >> 9) & 1) << 5); R = (st >> 1) * 16 + swz / 64; C = (st & 1) * 32 + (swz % 64) / 2; }
__host__ __device__ __forceinline__ int perm32(int rho) { const int n = rho >> 4, i = rho & 15; return 8 * (i >> 2) + 4 * n + (i & 3); }

struct Unit { int pm, pn; };
struct Gemm { const bf16_t* A; const bf16_t* Bt; int M, N, K, lda; };

struct StaticOrder {
    int nM, nN, nwg, G, c;
    __host__ __device__ void init(int M, int N, int G_, int c_) { nM = M / BM; nN = N / BM; nwg = nM * nN; G = G_; c = c_; }
    __host__ __device__ bool next(int i, Unit& u) const {
        const long L = (long)i * G + c; if (L >= nwg) return false;
        int wgid = (int)L; { const int q = nwg / NXCD, r = nwg % NXCD, xcd = wgid % NXCD, off = wgid / NXCD; wgid = (xcd < r ? xcd * (q + 1) : r * (q + 1) + (xcd - r) * q) + off; }
        const int nig = WGM * nN, gid = wgid / nig, fm = gid * WGM, gsz = (nM - fm) < WGM ? (nM - fm) : WGM;
        u.pm = fm + ((wgid % nig) % gsz); u.pn = (wgid % nig) / gsz; return true;
    }
    __device__ __forceinline__ void a_ready(const Unit&) const {}
    __device__ __forceinline__ void done(const Unit&) const {}
};

__device__ __forceinline__ unsigned cvt_pk_bf16(float lo, float hi) { unsigned r; asm volatile("v_cvt_pk_bf16_f32 %0, %1, %2" : "=v"(r) : "v"(lo), "v"(hi)); return r; }
template <class Epi, class Sched, bool ALIGN_EPI = false, bool SP2 = false>
__device__ __forceinline__ void gemm_phase(PG8_LAS unsigned char* lds, const Gemm g, const Sched& S, const Epi& E, int wave_s) {
    int ws_ = wave_s; asm volatile("" : "+s"(ws_));
    const int tid = ws_ * 64 + lane_id_here(), wid = ws_,
              lane = tid & 63, wr = wid >> 2, wc = wid & 3, fr = lane & 15, fq = lane >> 4;
    const int K = g.K, nt = K / BK;
    unsigned voffA[2], voffB[2];
#pragma unroll
    for (int i = 0; i < 2; ++i) { int R, C; stage_rc(tid * 16 + i * 8192, R, C); const int Rb = Epi::PERM ? ((R & ~31) + perm32(R & 31)) : R;
        voffA[i] = (unsigned)(R * g.lda + C) * 2u; voffB[i] = (unsigned)(Rb * K + C) * 2u; }
    const size_t kstep = (size_t)(BK * 2);
    const size_t hstepB = (size_t)HALF * K * 2, hstepA = (size_t)HALF * g.lda * 2;
    const size_t tstepB = 2 * hstepB, tstepA = 2 * hstepA;
    const unsigned ldsw = (unsigned)wid * 1024u;
    const int aoff = lds_byte(wr * 64 + fr, fq * 8), boff = lds_byte(wc * 32 + fr, fq * 8);
#define PG8_SA(b, h) (((b) * 2 + (h)) * HTB)
#define PG8_SB(b, h) ((4 + (b) * 2 + (h)) * HTB)
#define PG8_STAGE(bufoff, gbase, voff) do { _Pragma("unroll") for (int _i = 0; _i < 2; ++_i) \
        __builtin_amdgcn_global_load_lds((const unsigned*)((const char*)(gbase) + (voff)[_i]), (PG8_LAS unsigned*)(lds + (bufoff) + ldsw + _i * 8192), 16, 0, 0); } while (0)
#define PG8_LDA(dst, b, h) do { _Pragma("unroll") for (int m = 0; m < 4; ++m) _Pragma("unroll") for (int k = 0; k < 2; ++k) dst[m][k] = *(const PG8_LAS bf16x8*)(lds + PG8_SA(b, h) + aoff + m * 2048 + k * 1024); } while (0)
#define PG8_LDB(dst, b, h) do { _Pragma("unroll") for (int n = 0; n < 2; ++n) _Pragma("unroll") for (int k = 0; k < 2; ++k) dst[n][k] = *(const PG8_LAS bf16x8*)(lds + PG8_SB(b, h) + boff + n * 2048 + k * 1024); } while (0)
#define PG8_MMA(ai, bj, At, Bt) do { __builtin_amdgcn_s_setprio(1); _Pragma("unroll") for (int m = 0; m < 4; ++m) _Pragma("unroll") for (int n = 0; n < 2; ++n) _Pragma("unroll") for (int k = 0; k < 2; ++k) \
        acc[ai][bj][m][n] = __builtin_amdgcn_mfma_f32_16x16x32_bf16(Bt[n][k], At[m][k], acc[ai][bj][m][n], 0, 0, 0); __builtin_amdgcn_s_setprio(0); } while (0)
#define PG8_WAIT_V(n) asm volatile("s_waitcnt vmcnt(" #n ")" ::: "memory")
#define PG8_WAIT_L(n) asm volatile("s_waitcnt lgkmcnt(" #n ")" ::: "memory")
#define PG8_BAR __builtin_amdgcn_s_barrier()
#define PG8_SCHED __builtin_amdgcn_sched_barrier(0)
    Unit cur, nxt; int ui = 0;
    if (!S.next(0, cur)) return;
    f32x4 acc[2][2][4][2];
#pragma unroll
    for (int a = 0; a < 2; ++a)
#pragma unroll
        for (int b = 0; b < 2; ++b)
#pragma unroll
            for (int m = 0; m < 4; ++m)
#pragma unroll
                for (int n = 0; n < 2; ++n) acc[a][b][m][n] = (f32x4){0.f, 0.f, 0.f, 0.f};
    bf16x8 At[4][2], B0[2][2], B1[2][2];
    const char* cA = (const char*)g.A + (size_t)cur.pm * tstepA; const char* cB = (const char*)g.Bt + (size_t)cur.pn * tstepB;
    S.a_ready(cur);
    if constexpr (SP2) {
        PG8_STAGE(PG8_SB(0, 0), cB, voffB); PG8_STAGE(PG8_SB(0, 1), cB + hstepB, voffB); PG8_STAGE(PG8_SA(0, 0), cA, voffA); PG8_STAGE(PG8_SA(0, 1), cA + hstepA, voffA);
        if (wr == 1) PG8_BAR;
        PG8_WAIT_V(2); PG8_BAR;
        PG8_STAGE(PG8_SB(1, 0), cB + kstep, voffB); PG8_STAGE(PG8_SA(1, 0), cA + kstep, voffA); PG8_STAGE(PG8_SB(1, 1), cB + hstepB + kstep, voffB);
        PG8_WAIT_V(6); PG8_BAR;
    } else {
        PG8_STAGE(PG8_SB(0, 0), cB, voffB); PG8_STAGE(PG8_SA(0, 0), cA, voffA); PG8_STAGE(PG8_SB(0, 1), cB + hstepB, voffB); PG8_STAGE(PG8_SA(0, 1), cA + hstepA, voffA);
        if (wr == 1) PG8_BAR;
        PG8_WAIT_V(4); PG8_BAR;
        PG8_STAGE(PG8_SB(1, 0), cB + kstep, voffB); PG8_STAGE(PG8_SA(1, 0), cA + kstep, voffA); PG8_STAGE(PG8_SB(1, 1), cB + hstepB + kstep, voffB);
        PG8_WAIT_V(6); PG8_BAR;
    }
    for (;;) {
        const bool has_next = S.next(ui + 1, nxt);
        const char* nA = has_next ? (const char*)g.A + (size_t)nxt.pm * tstepA : cA; const char* nB = has_next ? (const char*)g.Bt + (size_t)nxt.pn * tstepB : cB;
        for (int t = 0; t < nt; t += 2) {
            const bool last = (t == nt - 2);
            const char* a1 = cA + (size_t)(t + 1) * kstep;
            const char* a2 = last ? nA : cA + (size_t)(t + 2) * kstep; const char* b2 = last ? nB : cB + (size_t)(t + 2) * kstep;
            const char* a3 = a2 + kstep; const char* b3 = b2 + kstep;
            if (last && has_next) S.a_ready(nxt);
            if constexpr (SP2) {
            PG8_LDB(B0, 0, 0); PG8_LDB(B1, 0, 1); PG8_SCHED; PG8_LDA(At, 0, 0); PG8_STAGE(PG8_SA(1, 1), a1 + hstepA, voffA);
            PG8_WAIT_V(8); PG8_WAIT_L(0); PG8_BAR; PG8_MMA(0, 0, At, B0); PG8_MMA(0, 1, At, B1); PG8_BAR; PG8_SCHED;
            PG8_LDA(At, 0, 1); PG8_STAGE(PG8_SB(0, 0), b2, voffB); PG8_STAGE(PG8_SB(0, 1), b2 + hstepB, voffB); PG8_STAGE(PG8_SA(0, 0), a2, voffA);
            PG8_WAIT_V(8); PG8_WAIT_L(0); PG8_BAR; PG8_MMA(1, 0, At, B0); PG8_MMA(1, 1, At, B1); PG8_BAR; PG8_SCHED;
            PG8_LDB(B0, 1, 0); PG8_LDB(B1, 1, 1); PG8_SCHED; PG8_LDA(At, 1, 0); PG8_STAGE(PG8_SA(0, 1), a2 + hstepA, voffA);
            PG8_WAIT_V(8); PG8_WAIT_L(0); PG8_BAR; PG8_MMA(0, 0, At, B0); PG8_MMA(0, 1, At, B1); PG8_BAR; PG8_SCHED;
            PG8_LDA(At, 1, 1); PG8_STAGE(PG8_SB(1, 0), b3, voffB); PG8_STAGE(PG8_SB(1, 1), b3 + hstepB, voffB); PG8_STAGE(PG8_SA(1, 0), a3, voffA);
            PG8_WAIT_V(8); PG8_WAIT_L(0); PG8_BAR; PG8_MMA(1, 0, At, B0); PG8_MMA(1, 1, At, B1); PG8_BAR; PG8_SCHED;
            } else {
            PG8_LDB(B0, 0, 0); PG8_SCHED; PG8_LDA(At, 0, 0); PG8_STAGE(PG8_SA(1, 1), a1 + hstepA, voffA);
            PG8_WAIT_L(8); PG8_BAR; PG8_WAIT_L(0); PG8_MMA(0, 0, At, B0); PG8_BAR; PG8_SCHED;
            PG8_LDB(B1, 0, 1); PG8_STAGE(PG8_SB(0, 0), b2, voffB);
            PG8_BAR; PG8_WAIT_L(0); PG8_MMA(0, 1, At, B1); PG8_BAR;
            PG8_LDA(At, 0, 1); PG8_STAGE(PG8_SA(0, 0), a2, voffA);
            PG8_BAR; PG8_WAIT_L(0); PG8_MMA(1, 0, At, B0); PG8_BAR; PG8_SCHED;
            PG8_STAGE(PG8_SB(0, 1), b2 + hstepB, voffB);
            PG8_WAIT_V(6); PG8_BAR; PG8_MMA(1, 1, At, B1); PG8_BAR;
            PG8_LDB(B0, 1, 0); PG8_SCHED; PG8_LDA(At, 1, 0); PG8_STAGE(PG8_SA(0, 1), a2 + hstepA, voffA);
            PG8_WAIT_L(8); PG8_BAR; PG8_WAIT_L(0); PG8_MMA(0, 0, At, B0); PG8_BAR; PG8_SCHED;
            PG8_LDB(B1, 1, 1); PG8_STAGE(PG8_SB(1, 0), b3, voffB);
            PG8_BAR; PG8_WAIT_L(0); PG8_MMA(0, 1, At, B1); PG8_BAR;
            PG8_LDA(At, 1, 1); PG8_STAGE(PG8_SA(1, 0), a3, voffA);
            PG8_BAR; PG8_WAIT_L(0); PG8_MMA(1, 0, At, B0); PG8_BAR; PG8_SCHED;
            PG8_STAGE(PG8_SB(1, 1), b3 + hstepB, voffB);
            PG8_WAIT_V(6); PG8_BAR; PG8_MMA(1, 1, At, B1); PG8_BAR;
            }
        }
        if constexpr (ALIGN_EPI) { if (wr == 0) PG8_BAR; }
        if constexpr (!Epi::AFTER_DRAIN) { const int el = lane_id_here(); E(acc, cur, wr, wc, el & 15, el >> 4); S.done(cur); }
        if (!has_next) break;
#pragma unroll
        for (int a = 0; a < 2; ++a)
#pragma unroll
            for (int b = 0; b < 2; ++b)
#pragma unroll
                for (int m = 0; m < 4; ++m)
#pragma unroll
                    for (int n = 0; n < 2; ++n) acc[a][b][m][n] = (f32x4){0.f, 0.f, 0.f, 0.f};
        cur = nxt; cA = nA; cB = nB; ++ui;
        if constexpr (ALIGN_EPI) { if (wr == 1) PG8_BAR; }
    }
    PG8_WAIT_V(0);
    if constexpr (!ALIGN_EPI) { if (wr == 0) PG8_BAR; }
    PG8_BAR;
    if constexpr (Epi::AFTER_DRAIN) { E.fused(acc, cur, wr, wc, fr, fq, lds, wid, lane); S.done(cur); }
#undef PG8_SA
#undef PG8_SB
#undef PG8_STAGE
#undef PG8_LDA
#undef PG8_LDB
#undef PG8_MMA
#undef PG8_WAIT_V
#undef PG8_WAIT_L
#undef PG8_BAR
#undef PG8_SCHED
}
}
namespace {
using pg8::f32x4; using pg8::u32x4; using pg8::Unit;
__device__ __forceinline__ float fast_sigmoid(float x) { return __builtin_amdgcn_rcpf(1.f + __expf(-x)); }
__device__ __forceinline__ f32x4 bf4_lo(unsigned a, unsigned b) { return (f32x4){__uint_as_float(a << 16), __uint_as_float(a & 0xffff0000u), __uint_as_float(b << 16), __uint_as_float(b & 0xffff0000u)}; }
__device__ __forceinline__ u32x4 pack8(const f32x4& v0, const f32x4& v1) { u32x4 w; w.x = pg8::cvt_pk_bf16(v0[0], v0[1]); w.y = pg8::cvt_pk_bf16(v0[2], v0[3]); w.z = pg8::cvt_pk_bf16(v1[0], v1[1]); w.w = pg8::cvt_pk_bf16(v1[2], v1[3]); return w; }
typedef GAS const unsigned long long* gcu64; typedef GAS unsigned long long* gu64;
__device__ __forceinline__ float rstd_of(gcu64 ssq, int row) { return rsqrtf((float)ssq[row] * (1.f / (1048576.f * D)) + 1e-6f); }
struct EpiInproj {
    static constexpr bool PERM = true, AFTER_DRAIN = false;
    gb16 P; gcf32 bias; gcu64 ssq;
    __device__ __forceinline__ void operator()(const f32x4 (&acc)[2][2][4][2], const Unit& u, int wr, int wc, int fr, int fq) const {
        const int row0 = u.pm * 256 + wr * 64 + fr, col0 = u.pn * 256 + wc * 32 + 8 * fq; gcf32 bb = bias + (size_t)(u.pm >> 3) * PC + col0;
        f32x4 bv[2][2];
#pragma unroll
        for (int bj = 0; bj < 2; ++bj)
#pragma unroll
            for (int n = 0; n < 2; ++n) bv[bj][n] = *(const GAS f32x4*)(bb + bj * 128 + 4 * n);
        float rsv[2][4];
#pragma unroll
        for (int ai = 0; ai < 2; ++ai)
#pragma unroll
            for (int m = 0; m < 4; ++m) rsv[ai][m] = rstd_of(ssq, row0 + ai * 128 + m * 16);
#pragma unroll
        for (int ai = 0; ai < 2; ++ai)
#pragma unroll
            for (int m = 0; m < 4; ++m) { const int row = row0 + ai * 128 + m * 16; gb16 rowp = P + (size_t)row * PC + col0; const float rs = rsv[ai][m];
#pragma unroll
                for (int bj = 0; bj < 2; ++bj) { const f32x4 v0 = acc[ai][bj][m][0] * rs + bv[bj][0], v1 = acc[ai][bj][m][1] * rs + bv[bj][1];
                    *(GAS u32x4*)(rowp + bj * 128) = pack8(v0, v1); } }
    }
};
struct EpiFfnIn {
    static constexpr bool PERM = true, AFTER_DRAIN = false;
    gb16 ACT; gcf32 bias; gcu64 ssq;
    __device__ __forceinline__ void operator()(const f32x4 (&acc)[2][2][4][2], const Unit& u, int wr, int wc, int fr, int fq) const {
        const int row0 = u.pm * 256 + wr * 64 + fr, col0 = u.pn * 128 + wc * 32 + 8 * fq; gcf32 bb = bias + (size_t)(u.pm >> 3) * 2 * DFF + u.pn * 256 + wc * 32 + 8 * fq;
        f32x4 bv[2][2];
#pragma unroll
        for (int bj = 0; bj < 2; ++bj)
#pragma unroll
            for (int n = 0; n < 2; ++n) bv[bj][n] = *(const GAS f32x4*)(bb + bj * 128 + 4 * n);
        float rsv[2][4];
#pragma unroll
        for (int ai = 0; ai < 2; ++ai)
#pragma unroll
            for (int m = 0; m < 4; ++m) rsv[ai][m] = rstd_of(ssq, row0 + ai * 128 + m * 16);
#pragma unroll
        for (int ai = 0; ai < 2; ++ai)
#pragma unroll
            for (int m = 0; m < 4; ++m) { const int row = row0 + ai * 128 + m * 16; const float rs = rsv[ai][m]; f32x4 o[2];
#pragma unroll
                for (int n = 0; n < 2; ++n) { const f32x4 g = acc[ai][0][m][n] * rs + bv[0][n], up = acc[ai][1][m][n] * rs + bv[1][n];
#pragma unroll
                    for (int e = 0; e < 4; ++e) o[n][e] = g[e] * fast_sigmoid(g[e]) * up[e]; }
                *(GAS u32x4*)(ACT + (size_t)row * DFF + col0) = pack8(o[0], o[1]); }
    }
};
constexpr int RES_CH = 2;
template <int e16> __device__ __forceinline__ float swz16(float v) { return __int_as_float(__builtin_amdgcn_ds_swizzle(__float_as_int(v), (e16 << 10) | 0x1F)); }
struct EpiRes {
    static constexpr bool PERM = true, AFTER_DRAIN = false;
    gcf32 Xin32; gcb16 Xin16; gf32 Xout32; gb16 Xout16;
    gcf32 g;
    gu64 ssq_out; gb16 Hn; gcf32 gain_n; gcf32 sc_n;
    __device__ __forceinline__ void operator()(const f32x4 (&acc)[2][2][4][2], const Unit& u, int wr, int wc, int fr, int fq) const {
        const int row0 = u.pm * 256 + wr * 64 + fr, col0 = u.pn * 256 + wc * 32 + 8 * fq; const size_t boff = (size_t)(u.pm >> 3) * 6 * D + col0;
        f32x4 gv[2][2], gm[2][2];
#pragma unroll
        for (int bj = 0; bj < 2; ++bj)
#pragma unroll
            for (int n = 0; n < 2; ++n) { gv[bj][n] = *(const GAS f32x4*)(g + boff + bj * 128 + 4 * n);
                if (Hn) { const f32x4 ga = *(const GAS f32x4*)(gain_n + col0 + bj * 128 + 4 * n), sc = *(const GAS f32x4*)(sc_n + boff + bj * 128 + 4 * n); gm[bj][n] = ga * (sc + 1.0f); } }
#pragma unroll
        for (int am = 0; am < 8; am += RES_CH) {
            f32x4 xi[RES_CH][2][2];
            if (Xin16) {
                u32x4 xw[RES_CH][2];
#pragma unroll
                for (int mm = 0; mm < RES_CH; ++mm)
#pragma unroll
                    for (int bj = 0; bj < 2; ++bj) xw[mm][bj] = *(const GAS u32x4*)(Xin16 + (size_t)(row0 + ((am + mm) >> 2) * 128 + ((am + mm) & 3) * 16) * D + col0 + bj * 128);
#pragma unroll
                for (int mm = 0; mm < RES_CH; ++mm)
#pragma unroll
                    for (int bj = 0; bj < 2; ++bj) { xi[mm][bj][0] = bf4_lo(xw[mm][bj].x, xw[mm][bj].y); xi[mm][bj][1] = bf4_lo(xw[mm][bj].z, xw[mm][bj].w); }
            } else {
#pragma unroll
                for (int mm = 0; mm < RES_CH; ++mm)
#pragma unroll
                    for (int bj = 0; bj < 2; ++bj)
#pragma unroll
                        for (int n = 0; n < 2; ++n) xi[mm][bj][n] = *(const GAS f32x4*)(Xin32 + (size_t)(row0 + ((am + mm) >> 2) * 128 + ((am + mm) & 3) * 16) * D + col0 + bj * 128 + 4 * n);
            }
#pragma unroll
            for (int mm = 0; mm < RES_CH; ++mm) { const int ai = (am + mm) >> 2, m = (am + mm) & 3, row = row0 + ai * 128 + m * 16; const size_t off = (size_t)row * D + col0; float s = 0.f;
#pragma unroll
                for (int bj = 0; bj < 2; ++bj) { f32x4 xn[2];
#pragma unroll
                    for (int n = 0; n < 2; ++n) { xn[n] = xi[mm][bj][n] + gv[bj][n] * acc[ai][bj][m][n];
                        s += (xn[n][0] * xn[n][0] + xn[n][1] * xn[n][1]) + (xn[n][2] * xn[n][2] + xn[n][3] * xn[n][3]); }
                    if (Xout16) *(GAS u32x4*)(Xout16 + off + bj * 128) = pack8(xn[0], xn[1]);
                    else { *(GAS f32x4*)(Xout32 + off + bj * 128) = xn[0]; *(GAS f32x4*)(Xout32 + off + bj * 128 + 4) = xn[1]; }
                    if (Hn) *(GAS u32x4*)(Hn + off + bj * 128) = pack8(xn[0] * gm[bj][0], xn[1] * gm[bj][1]); }
                s += swz16<16>(s); { auto rr = __builtin_amdgcn_permlane32_swap(__float_as_uint(s), __float_as_uint(s), false, false); s = __uint_as_float(rr[0]) + __uint_as_float(rr[1]); }
                if (fq == 0) atomicAdd((unsigned long long*)(ssq_out + row), (unsigned long long)(s * 1048576.f + 0.5f)); } }
    }
};
struct EpiMod {
    static constexpr bool PERM = false, AFTER_DRAIN = false;
    gf32 mod; gcf32 b_mod; gb16 sh1, sh2;
    __device__ __forceinline__ void operator()(const f32x4 (&acc)[2][2][4][2], const Unit& u, int wr, int wc, int fr, int fq) const {
        if (wr != 0) return;
        const int col0 = u.pn * 256 + wc * 32 + 4 * fq;
#pragma unroll
        for (int bj = 0; bj < 2; ++bj)
#pragma unroll
            for (int n = 0; n < 2; ++n) { const int c = col0 + bj * 128 + n * 16; const f32x4 v = acc[0][bj][0][n] + *(const GAS f32x4*)(b_mod + c);
                *(GAS f32x4*)(mod + (size_t)fr * 6 * D + c) = v;
                gb16 sh = c < D ? sh1 + c : (c >= 3 * D && c < 4 * D) ? sh2 + (c - 3 * D) : (gb16)nullptr;
                if (sh) { u32x2v w; w.x = pg8::cvt_pk_bf16(v[0], v[1]); w.y = pg8::cvt_pk_bf16(v[2], v[3]); *(GAS u32x2v*)(sh + (size_t)fr * D) = w; } }
    }
};
struct EpiBias {
    static constexpr bool PERM = false, AFTER_DRAIN = false;
    gf32 out; int ncols; gcf32 add; int add_from;
    __device__ __forceinline__ void operator()(const f32x4 (&acc)[2][2][4][2], const Unit& u, int wr, int wc, int fr, int fq) const {
        if (wr != 0) return;
        const int col0 = u.pn * 256 + wc * 32 + 4 * fq;
#pragma unroll
        for (int bj = 0; bj < 2; ++bj)
#pragma unroll
            for (int n = 0; n < 2; ++n) { const int c = col0 + bj * 128 + n * 16; f32x4 v = acc[0][bj][0][n];
                if (add && c >= add_from) v = v + *(const GAS f32x4*)(add + (c - add_from));
                *(GAS f32x4*)(out + (size_t)fr * ncols + c) = v; }
    }
};
struct EpiGlu {
    static constexpr bool PERM = true, AFTER_DRAIN = false;
    gb16 P;
    __device__ __forceinline__ void operator()(const f32x4 (&acc)[2][2][4][2], const Unit& u, int wr, int wc, int fr, int fq) const {
        const int row0 = u.pm * 256 + wr * 64 + fr, col0 = u.pn * 128 + wc * 32 + 8 * fq;
#pragma unroll
        for (int ai = 0; ai < 2; ++ai) {
            u32x4 gwv[4];
#pragma unroll
            for (int m = 0; m < 4; ++m) gwv[m] = *(const GAS u32x4*)(P + (size_t)(row0 + ai * 128 + m * 16) * PC + PC_G + D + col0);
#pragma unroll
            for (int m = 0; m < 4; ++m) { gb16 rowp = P + (size_t)(row0 + ai * 128 + m * 16) * PC;
                const u32x4 gw = gwv[m]; f32x4 g0 = bf4_lo(gw.x, gw.y), g1 = bf4_lo(gw.z, gw.w); f32x4 o[2];
#pragma unroll
                for (int e = 0; e < 4; ++e) { g0[e] = fast_sigmoid(g0[e]); g1[e] = fast_sigmoid(g1[e]); }
#pragma unroll
                for (int e = 0; e < 4; ++e) { o[0][e] = g0[e] * acc[ai][0][m][0][e] * fast_sigmoid(acc[ai][1][m][0][e]); o[1][e] = g1[e] * acc[ai][0][m][1][e] * fast_sigmoid(acc[ai][1][m][1][e]); }
                *(GAS u32x4*)(rowp + col0) = pack8(o[0], o[1]); } }
    }
};
struct EpiMixAcc {
    static constexpr bool PERM = true, AFTER_DRAIN = false;
    gb16 P; int gate_off;
    __device__ __forceinline__ void operator()(const f32x4 (&acc)[2][2][4][2], const Unit& u, int wr, int wc, int fr, int fq) const {
        const int row0 = u.pm * 256 + wr * 64 + fr, col0 = u.pn * 256 + wc * 32 + 8 * fq;
#pragma unroll
        for (int am = 0; am < 8; ++am) { const int ai = am >> 2, m0 = am & 3;
            u32x4 gwv[1][2], owv[1][2];
#pragma unroll
            for (int mm = 0; mm < 1; ++mm)
#pragma unroll
                for (int bj = 0; bj < 2; ++bj) { gcb16 rp = P + (size_t)(row0 + ai * 128 + (m0 + mm) * 16) * PC + col0 + bj * 128; gwv[mm][bj] = *(const GAS u32x4*)(rp + gate_off); owv[mm][bj] = *(const GAS u32x4*)rp; }
#pragma unroll
            for (int mm = 0; mm < 1; ++mm) { const int m = m0 + mm; gb16 rowp = P + (size_t)(row0 + ai * 128 + m * 16) * PC;
#pragma unroll
                for (int bj = 0; bj < 2; ++bj) { const int c = col0 + bj * 128;
                    const u32x4 gw = gwv[mm][bj], ow = owv[mm][bj];
                    f32x4 g0 = bf4_lo(gw.x, gw.y), g1 = bf4_lo(gw.z, gw.w);
#pragma unroll
                    for (int e = 0; e < 4; ++e) { g0[e] = fast_sigmoid(g0[e]); g1[e] = fast_sigmoid(g1[e]); }
                    const f32x4 v0 = bf4_lo(ow.x, ow.y) + g0 * acc[ai][bj][m][0], v1 = bf4_lo(ow.z, ow.w) + g1 * acc[ai][bj][m][1];
                    *(GAS u32x4*)(rowp + c) = pack8(v0, v1); } } }
    }
};

#define XB_TMO      128
#define XB_XCNT(j)  (256  + 64 * (j))
#define XB_XSUB(j)  (1280 + 64 * (j))
#define XB_XGEN(j)  (2304 + 64 * (j))
#define XB_TOP      3328
#define XB_TOPGEN   3392
#define XCD_BAR_WORDS 3456
#define XB_SPIN_CAP (1u << 20)
__device__ __forceinline__ unsigned xb_ld(unsigned* p)              { return __hip_atomic_load(p, __ATOMIC_RELAXED, __HIP_MEMORY_SCOPE_AGENT); }
__device__ __forceinline__ unsigned xb_add(unsigned* p, unsigned v) { return __hip_atomic_fetch_add(p, v, __ATOMIC_RELAXED, __HIP_MEMORY_SCOPE_AGENT); }
__device__ __forceinline__ unsigned xb_xcc_id() { return (unsigned)__builtin_amdgcn_s_getreg((3 << 11) | 20) & 0xFu; }
#define XB_SPIN(cond, bar) do { unsigned _sp = 0; while (cond) { __builtin_amdgcn_s_sleep(1); \
    if ((++_sp & 255u) == 0u) { if (xb_ld(&(bar)[XB_TMO])) break; if (_sp > XB_SPIN_CAP) { atomicAdd(&(bar)[XB_TMO], 1u); break; } } } } while (0)
struct XcdBarrier { unsigned* bar; unsigned x; volatile LAS unsigned* st; };
__device__ __forceinline__ XcdBarrier xcd_barrier_post(unsigned* bar, volatile LAS unsigned* st, int wave_s) {
    XcdBarrier b; b.bar = bar; b.x = xb_xcc_id(); b.st = st;
    if (wave_s == 0 && lane_id_here() == 0) (void)xb_add(&bar[XB_XCNT(b.x)], 1u);
    return b;
}
__device__ __forceinline__ void xcd_barrier_complete(unsigned* bar, unsigned x, unsigned& nloc, unsigned& nx) {
    const unsigned G = gridDim.x * gridDim.y * gridDim.z;
    unsigned sum, cnt, mine, sp = 0u;
    for (;;) {
        sum = 0u; cnt = 0u; mine = 0u;
#pragma unroll
        for (unsigned j = 0; j < 16; ++j) { const unsigned c = xb_ld(&bar[XB_XCNT(j)]); sum += c; cnt += (c > 0u) ? 1u : 0u; mine = (j == x) ? c : mine; }
        if (sum == G) break;
        __builtin_amdgcn_s_sleep(1);
        if ((++sp & 255u) == 0u) { if (xb_ld(&bar[XB_TMO])) break; if (sp > XB_SPIN_CAP) { atomicAdd(&bar[XB_TMO], 1u); break; } }
    }
    nloc = mine > 0u ? mine : 1u; nx = cnt > 0u ? cnt : 1u;
}
__device__ __forceinline__ void xcd_barrier(const XcdBarrier& b, int wave_s) {
    asm volatile("s_waitcnt vmcnt(0)" ::: "memory");
    __syncthreads();
    if (wave_s == 0 && lane_id_here() == 0) {
        unsigned* bar = b.bar; unsigned bx = b.x; asm volatile("" : "+s"(bar), "+s"(bx));
        __builtin_amdgcn_s_waitcnt(0);
        unsigned nloc = b.st[0], nx = b.st[1];
        if (nloc == 0u) { xcd_barrier_complete(bar, bx, nloc, nx); b.st[0] = nloc; b.st[1] = nx; }
        const unsigned old = xb_add(&bar[XB_XSUB(bx)], 1u);
        const unsigned gen = old / nloc;
        if (old + 1u == (gen + 1u) * nloc) {
            __builtin_amdgcn_fence(__ATOMIC_RELEASE, "agent");
            asm volatile("s_waitcnt vmcnt(0)" ::: "memory");
            const unsigned og = xb_add(&bar[XB_TOP], 1u);
            const unsigned tg = og / nx;
            if (og + 1u == (tg + 1u) * nx) xb_add(&bar[XB_TOPGEN], 1u);
            else XB_SPIN(xb_ld(&bar[XB_TOPGEN]) == tg, bar);
            __builtin_amdgcn_fence(__ATOMIC_ACQUIRE, "agent");
            xb_add(&bar[XB_XGEN(bx)], 1u);
            asm volatile("s_waitcnt vmcnt(0)" ::: "memory");
        } else {
            XB_SPIN(xb_ld(&bar[XB_XGEN(bx)]) == gen, bar);
            __builtin_amdgcn_fence(__ATOMIC_ACQUIRE, "agent");
            asm volatile("s_waitcnt vmcnt(0)" ::: "memory");
        }
    }
    __syncthreads();
}


struct Args { const float* in[24]; float* out; unsigned char* ws; };

template <int K> __device__ __forceinline__ float swz_xor(float v) { return __int_as_float(__builtin_amdgcn_ds_swizzle(__float_as_int(v), (K << 10) | 0x1F)); }
__device__ __forceinline__ float wave_sum(float v) { v += swz_xor<1>(v); v += swz_xor<2>(v); v += swz_xor<4>(v); v += swz_xor<8>(v); v += swz_xor<16>(v);
    auto rr = __builtin_amdgcn_permlane32_swap(__float_as_uint(v), __float_as_uint(v), false, false); return __uint_as_float(rr[0]) + __uint_as_float(rr[1]); }
__device__ __forceinline__ unsigned sortable(float f) { const unsigned b = __float_as_uint(f); return (b & 0x80000000u) ? ~b : (b | 0x80000000u); }
__device__ __forceinline__ float unsortable(unsigned u) { return __uint_as_float((u & 0x80000000u) ? (u ^ 0x80000000u) : ~u); }

__device__ __forceinline__ void ph_a16(gcf32 c, gb16 A16, gu64 ssq, int gw, int lane) {
    for (int it = gw * 64 + lane; it < 4 * M; it += NGW * 64) ssq[M + it] = 0ull;
    for (int it = gw * 64 + lane; it < 5 * 256 * D / 8; it += NGW * 64) { const int e = it * 8, mtx = e / (256 * D), r = (e / D) & 255, k = e & (D - 1);
        u32x4 w = {0u, 0u, 0u, 0u};
        if (mtx == 0 && r < 16) { gcf32 cp = c + r * D + k; w.x = pg8::cvt_pk_bf16(siluf_(cp[0]), siluf_(cp[1])); w.y = pg8::cvt_pk_bf16(siluf_(cp[2]), siluf_(cp[3])); w.z = pg8::cvt_pk_bf16(siluf_(cp[4]), siluf_(cp[5])); w.w = pg8::cvt_pk_bf16(siluf_(cp[6]), siluf_(cp[7])); }
        if (mtx == 0 || r >= 16) *(GAS u32x4*)(A16 + e) = w; }
}
__device__ __forceinline__ void ph_h0(gcf32 x, gcf32 gain, gcf32 modl, int sc_off, gb16 H, gu64 ssq, int gw, int ngw, int lane) {
    for (int t0 = 4 * gw; t0 < M; t0 += 4 * ngw) {
        const int b = t0 / S; f32x4v v[4][4]; float s[4];
#pragma unroll
        for (int q = 0; q < 4; ++q) { const GAS f32x4v* xr = (const GAS f32x4v*)(x + (size_t)(t0 + q) * D) + lane;
#pragma unroll
            for (int j = 0; j < 4; ++j) v[q][j] = xr[64 * j]; }
        gcf32 mb = modl + (size_t)b * 6 * D; f32x4v gm[4];
#pragma unroll
        for (int j = 0; j < 4; ++j) { const int k = 4 * lane + 256 * j; const f32x4v g = *(const GAS f32x4v*)(gain + k), sc = *(const GAS f32x4v*)(mb + sc_off + k); gm[j] = g * (sc + 1.0f); }
#pragma unroll
        for (int q = 0; q < 4; ++q) { float a = 0.f;
#pragma unroll
            for (int j = 0; j < 4; ++j) a += v[q][j].x * v[q][j].x + v[q][j].y * v[q][j].y + v[q][j].z * v[q][j].z + v[q][j].w * v[q][j].w;
            s[q] = wave_sum(a); }
        if (lane < 4) ssq[t0 + lane] = (unsigned long long)((lane == 0 ? s[0] : lane == 1 ? s[1] : lane == 2 ? s[2] : s[3]) * 1048576.f + 0.5f);
#pragma unroll
        for (int q = 0; q < 4; ++q)
#pragma unroll
            for (int j = 0; j < 4; ++j) { const int k = 4 * lane + 256 * j; const f32x4v o = v[q][j] * gm[j];
                u32x2v w; w.x = pg8::cvt_pk_bf16(o.x, o.y); w.y = pg8::cvt_pk_bf16(o.z, o.w); *(GAS u32x2v*)(H + (size_t)(t0 + q) * D + k) = w; }
    }
}
__device__ __forceinline__ void ph_final_norm(gcf32 x, gf32 out, gcf32 gain, gcu64 ssq, int gw, int lane) {
    f32x4v g[4];
#pragma unroll
    for (int j = 0; j < 4; ++j) g[j] = *(const GAS f32x4v*)(gain + 4 * lane + 256 * j);
    for (int t0 = 4 * gw; t0 < M; t0 += 4 * NGW) {
        f32x4v v[4][4]; float rs[4];
#pragma unroll
        for (int q = 0; q < 4; ++q) { const GAS f32x4v* xr = (const GAS f32x4v*)(x + (size_t)(t0 + q) * D) + lane; rs[q] = rstd_of(ssq, t0 + q);
#pragma unroll
            for (int j = 0; j < 4; ++j) v[q][j] = xr[64 * j]; }
#pragma unroll
        for (int q = 0; q < 4; ++q) { GAS f32x4v* xr = (GAS f32x4v*)(out + (size_t)(t0 + q) * D) + lane;
#pragma unroll
            for (int j = 0; j < 4; ++j) xr[64 * j] = v[q][j] * g[j] * rs[q]; }
    }
}
__device__ __forceinline__ f32x4 ld_bf4(gcb16 p) { const u32x2v w = *(const GAS u32x2v*)p; return bf4_lo(w.x, w.y); }
__device__ __forceinline__ void ph_conv(gcb16 P, gcf32 conv_w, gb16 CONVA, int gw, int lane) {
    const int j0 = 4 * lane;
    const f32x4 w0 = *(const GAS f32x4*)(conv_w + j0), w1 = *(const GAS f32x4*)(conv_w + 256 + j0), w2 = *(const GAS f32x4*)(conv_w + 512 + j0);
    for (int run = gw; run < M / 16; run += NGW) {
        const int t0 = 16 * run; f32x4 z1 = {0.f, 0.f, 0.f, 0.f}, z2 = {0.f, 0.f, 0.f, 0.f};
        if ((t0 & (S - 1)) != 0) { gcb16 p1 = P + (size_t)(t0 - 1) * PC + j0, p2 = P + (size_t)(t0 - 2) * PC + j0; z1 = ld_bf4(p1 + 256) * ld_bf4(p1 + 512); z2 = ld_bf4(p2 + 256) * ld_bf4(p2 + 512); }
#pragma unroll 4
        for (int i = 0; i < 16; ++i) { gcb16 p = P + (size_t)(t0 + i) * PC + j0;
            const f32x4 z0 = ld_bf4(p + 256) * ld_bf4(p + 512), y = ld_bf4(p) * (w0 * z2 + w1 * z1 + w2 * z0);
            u32x2v o; o.x = pg8::cvt_pk_bf16(y[0], y[1]); o.y = pg8::cvt_pk_bf16(y[2], y[3]); *(GAS u32x2v*)(CONVA + (size_t)(t0 + i) * 256 + j0) = o;
            z2 = z1; z1 = z0; }
    }
}

typedef short bf16x8_t __attribute__((ext_vector_type(8)));
typedef float f32x16_t __attribute__((ext_vector_type(16)));
#define MFMA32(a, b, c) __builtin_amdgcn_mfma_f32_32x32x16_bf16((a), (b), (c), 0, 0, 0)
__device__ __forceinline__ int crow16(int r, int h) { return (r & 3) + 8 * (r >> 2) + 4 * h; }
__device__ __forceinline__ void ph_ssm_params(gcf32 a_re, gcf32 a_im, gcf32 log_dt, gcf32 b_re, gcf32 b_im, gf32 SSMP, gf32 AP, int gw, int lane) {
    for (int it = gw * 64 + lane; it < NL * 1024; it += NGW * 64) {
        const int l = it >> 10, gp = it & 1023, g = gp >> 6;
        const double dt = exp((double)log_dt[l * 16 + g]), ar = a_re[l * 1024 + gp], ai = a_im[l * 1024 + gp];
        const double mag = exp(dt * ar), abr = mag * cos(dt * ai), abi = mag * sin(dt * ai);
        const double den = ar * ar + ai * ai, nr = abr - 1.0, ni = abi;
        const double cr = (nr * ar + ni * ai) / den, ci = (ni * ar - nr * ai) / den;
        gf32 o = SSMP + (size_t)l * SSMP_LAYER;
        o[gp * 2] = (float)abr; o[gp * 2 + 1] = (float)abi;
        for (int j = 0; j < 16; ++j) { const double br = b_re[(l * 1024 + gp) * 16 + j], bi = b_im[(l * 1024 + gp) * 16 + j];
            o[2048 + (gp * 16 + j) * 2] = (float)(cr * br - ci * bi); o[2048 + (gp * 16 + j) * 2 + 1] = (float)(cr * bi + ci * br); }
    }
    for (int it = gw * 64 + lane; it < NL * 1024 * 65; it += NGW * 64) {
        const int d = it % 65, lgp = it / 65, l = lgp >> 10, gp = lgp & 1023, g = gp >> 6;
        const double dt = exp((double)log_dt[l * 16 + g]), ar = a_re[l * 1024 + gp], ai = a_im[l * 1024 + gp];
        const double m2 = exp((double)d * dt * ar), ang = (double)d * dt * ai;
        AP[(size_t)it * 2] = (float)(m2 * cos(ang)); AP[(size_t)it * 2 + 1] = (float)(m2 * sin(ang));
    }
}
__device__ __forceinline__ void ph_ssm_kd(gcf32 a_re, gcf32 a_im, gcf32 log_dt, gcf32 b_re, gcf32 b_im, gcf32 c_re, gcf32 c_im, gf32 KD, LAS float* scr, int gw, int lane) {
    for (int it = gw; it < NL * 16 * 64; it += NGW) {
        const int d = it & 63, lg = it >> 6;
        { const int gp = lg * 64 + lane; const double dt = exp((double)log_dt[lg]), ar = a_re[gp], ai = a_im[gp];
          const double mag = exp(dt * ar), abr = mag * cos(dt * ai), abi = mag * sin(dt * ai), den = ar * ar + ai * ai, nr = abr - 1.0, ni = abi;
          const double cr = (nr * ar + ni * ai) / den, ci = (ni * ar - nr * ai) / den, md = exp((double)d * dt * ar), ang = (double)d * dt * ai, pr = md * cos(ang), pi = md * sin(ang);
          asm volatile("s_waitcnt lgkmcnt(0)" ::: "memory");
          scr[2 * lane] = (float)(pr * cr - pi * ci); scr[2 * lane + 1] = (float)(pr * ci + pi * cr); }
        asm volatile("s_waitcnt lgkmcnt(0)" ::: "memory");
        const int jp = lane & 15, jq = lane >> 4; float acc[4] = {0.f, 0.f, 0.f, 0.f};
        gcf32 br = b_re + (size_t)lg * 1024 + jp, bi = b_im + (size_t)lg * 1024 + jp, cr_ = c_re + (size_t)lg * 1024 + jq * 64, ci_ = c_im + (size_t)lg * 1024 + jq * 64;
#pragma unroll 4
        for (int p = 0; p < 64; ++p) { const float er = scr[2 * p], ei = scr[2 * p + 1], b0 = br[p * 16], b1 = bi[p * 16]; const float zr = er * b0 - ei * b1, zi = er * b1 + ei * b0;
#pragma unroll
            for (int i = 0; i < 4; ++i) acc[i] += cr_[i * 256 + p] * zr - ci_[i * 256 + p] * zi; }
#pragma unroll
        for (int i = 0; i < 4; ++i) KD[((size_t)lg * 64 + d) * 256 + (jq + 4 * i) * 16 + jp] = acc[i];
    }
}
__device__ __forceinline__ void ph_ssm_frags(gcf32 c_re, gcf32 c_im, gcf32 SSMP, gcf32 AP, gcf32 KD, gu8 T, int gw, int lane) {
    const int n = lane & 31, h = lane >> 5;
    for (int f = gw; f < NL * 16 * SSM_NFRAG; f += NGW) {
        const int l = f / (16 * SSM_NFRAG), g = (f / SSM_NFRAG) & 15, k = f % SSM_NFRAG;
        gcf32 ap = AP + (size_t)((l * 16 + g) * 64) * 65 * 2;
        gcf32 bb = SSMP + (size_t)l * SSMP_LAYER + 2048 + (size_t)(g * 64) * 32;
        gcf32 cr = c_re + (size_t)((l * 16 + g) * 16) * 64; gcf32 ci = c_im + (size_t)((l * 16 + g) * 16) * 64;
        float v[8];
        if (k < 65) {
            const int tt = n >> 4, j = n & 15, d = k - 1 + tt;
            if (d >= 0) { gcf32 kd = KD + ((size_t)((l * 16 + g) * 64 + d)) * 256 + j * 16 + 8 * h; const f32x4 k0 = *(const GAS f32x4*)kd, k1 = *(const GAS f32x4*)(kd + 4);
                v[0] = k0[0]; v[1] = k0[1]; v[2] = k0[2]; v[3] = k0[3]; v[4] = k1[0]; v[5] = k1[1]; v[6] = k1[2]; v[7] = k1[3]; }
            else {
#pragma unroll
                for (int e = 0; e < 8; ++e) v[e] = 0.f; }
        } else if (k < 65 + 256) {
            const int kk = k - 65, nb = kk >> 6, s = kk & 63, ng = 32 * nb + n, ri = ng >> 6, p = ng & 63;
            const float adr = ap[(p * 65 + 63 - s) * 2], adi = ap[(p * 65 + 63 - s) * 2 + 1];
#pragma unroll
            for (int e = 0; e < 8; ++e) { const float br = bb[(p * 16 + 8 * h + e) * 2], bi = bb[(p * 16 + 8 * h + e) * 2 + 1]; v[e] = ri == 0 ? adr * br - adi * bi : adr * bi + adi * br; }
        } else {
            const int kk = k - 321, nb = kk >> 3, ks = kk & 7, t = 2 * nb + (n >> 4), j = n & 15;
#pragma unroll
            for (int e = 0; e < 8; ++e) { const int kg = 16 * ks + 8 * h + e, ri = kg >> 6, p = kg & 63;
                const float adr = ap[(p * 65 + t + 1) * 2], adi = ap[(p * 65 + t + 1) * 2 + 1], cjr = cr[j * 64 + p], cji = ci[j * 64 + p];
                v[e] = ri == 0 ? cjr * adr - cji * adi : -(cjr * adi + cji * adr); }
        }
        u32x4 o; o.x = pg8::cvt_pk_bf16(v[0], v[1]); o.y = pg8::cvt_pk_bf16(v[2], v[3]); o.z = pg8::cvt_pk_bf16(v[4], v[5]); o.w = pg8::cvt_pk_bf16(v[6], v[7]);
        *(GAS u32x4*)(T + (size_t)l * SSMT_LAYER + ((size_t)(g * SSM_NFRAG + k) * 64 + lane) * 16) = o;
    }
}
constexpr int SSM_UROW = 2064, SSM_HROW = 272, SSM_SL_OFF = 32 * SSM_UROW, SSM_HP_OFF = SSM_SL_OFF + 16384, SSM_LDS = SSM_HP_OFF + 32 * SSM_HROW;
__device__ __forceinline__ void ssm_fast_item(LAS unsigned char* lds, gcb16 P, gcu8 T  , gcf32 AP  , gcf32 d_skip, gb16 Z, int b, int g, int wave_s) {
    const int lane = lane_id_here(), tid = wave_s * 64 + lane, n = lane & 31, h = lane >> 5;
    gcu8 Tg = T + (size_t)g * SSM_NFRAG * 1024;
#pragma unroll
    for (int i = 0; i < 4; ++i) { const int tok = tid + 512 * i; const GAS u32x4* src = (const GAS u32x4*)(P + (size_t)(b * S + tok) * PC + PC_SSM + g * 16);
        const u32x4 v0 = src[0], v1 = src[1]; LAS u32x4* dst = (LAS u32x4*)(lds + (tok >> 6) * SSM_UROW + (tok & 63) * 32); dst[0] = v0; dst[1] = v1; }
    __syncthreads();
    {
        int ws2 = wave_s; asm volatile("" : "+s"(ws2));
        const int nb = ws2 & 3, kh = ws2 >> 2; f32x16_t acc;
#pragma unroll
        for (int r = 0; r < 16; ++r) acc[r] = 0.f;
        {
            gcu8 bp = Tg + ((size_t)(65 + nb * 64 + 32 * kh) * 64 + lane) * 16; const LAS unsigned char* ap = lds + n * SSM_UROW + (32 * kh) * 32 + 16 * h;
            bf16x8_t cur[8], nxt[8];
#pragma unroll
            for (int i = 0; i < 8; ++i) cur[i] = *(const GAS bf16x8_t*)(bp + i * 1024);
#pragma unroll
            for (int bt = 0; bt < 4; ++bt) {
                if (bt < 3) {
#pragma unroll
                    for (int i = 0; i < 8; ++i) nxt[i] = *(const GAS bf16x8_t*)(bp + (bt * 8 + 8 + i) * 1024); }
#pragma unroll
                for (int i = 0; i < 8; ++i) { const bf16x8_t a = *(const LAS bf16x8_t*)(ap + (bt * 8 + i) * 32); acc = MFMA32(a, cur[i], acc); }
#pragma unroll
                for (int i = 0; i < 8; ++i) cur[i] = nxt[i];
            }
        }
        LAS float* SL = (LAS float*)(lds + SSM_SL_OFF);
        if (kh == 0) {
#pragma unroll
            for (int r = 0; r < 16; ++r) SL[crow16(r, h) * 128 + 32 * nb + n] = acc[r]; }
        __syncthreads();
        if (kh == 1) {
#pragma unroll
            for (int r = 0; r < 16; ++r) SL[crow16(r, h) * 128 + 32 * nb + n] += acc[r]; }
        __syncthreads();
        if (wave_s == 0) {
            const float ar = AP[(size_t)((g * 64 + lane) * 65 + 64) * 2], ai = AP[(size_t)((g * 64 + lane) * 65 + 64) * 2 + 1];
            float hr = 0.f, hi = 0.f;
            for (int c = 0; c < 32; ++c) {
                LAS bf16_t* hp = (LAS bf16_t*)(lds + SSM_HP_OFF + c * SSM_HROW); hp[lane] = f2bf(hr); hp[64 + lane] = f2bf(hi);
                const float sr = SL[c * 128 + lane], si = SL[c * 128 + 64 + lane];
                const float nr = ar * hr - ai * hi + sr, ni = ar * hi + ai * hr + si; hr = nr; hi = ni;
            }
        }
        __syncthreads();
    }
    for (int q = 0; q < 4; ++q) {
        const int nb = (q == 0) ? wave_s : (q == 1) ? 15 - wave_s : (q == 2) ? 16 + wave_s : 31 - wave_s;
        f32x16_t acc;
#pragma unroll
        for (int r = 0; r < 16; ++r) acc[r] = 0.f;
        const int ns = 2 * nb + 2, total = ns + 8;
        {
            gcu8 tp = Tg + ((size_t)(2 * nb + 1) * 64 + lane) * 16, cp = Tg + ((size_t)(321 + nb * 8) * 64 + lane) * 16;
            const LAS unsigned char* ua = lds + n * SSM_UROW + 16 * h; const LAS unsigned char* ha = lds + SSM_HP_OFF + n * SSM_HROW + 16 * h;
#define SSM_BLOAD(dst, k) do { const int k_ = (k); if (k_ < total) dst = *(const GAS bf16x8_t*)(k_ < ns ? tp - (size_t)k_ * 1024 : cp + (size_t)(k_ - ns) * 1024); } while (0)
            bf16x8_t cur[8], nxt[8];
#pragma unroll
            for (int i = 0; i < 8; ++i) SSM_BLOAD(cur[i], i);
            for (int base = 0; base < total; base += 8) {
#pragma unroll
                for (int i = 0; i < 8; ++i) SSM_BLOAD(nxt[i], base + 8 + i);
#pragma unroll
                for (int i = 0; i < 8; ++i) { const int k = base + i;
                    if (k < total) { const bf16x8_t a = *(const LAS bf16x8_t*)(k < ns ? ua + k * 32 : ha + (k - ns) * 32); acc = MFMA32(a, cur[i], acc); } }
#pragma unroll
                for (int i = 0; i < 8; ++i) cur[i] = nxt[i];
            }
#undef SSM_BLOAD
        }
        const int t = 2 * nb + (n >> 4), j = n & 15; const float dsk = d_skip[g * 16 + j];
#pragma unroll
        for (int r = 0; r < 16; ++r) { const int c = crow16(r, h);
            const float u = bf2f(*(const LAS bf16_t*)(lds + c * SSM_UROW + (t * 16 + j) * 2));
            Z[(size_t)(b * S + c * 64 + t) * 256 + g * 16 + j] = f2bf(gelu_tanh(acc[r] + dsk * u)); }
    }
    __syncthreads();
}

typedef short s16x4_t __attribute__((ext_vector_type(4)));
typedef float f32x2_t __attribute__((ext_vector_type(2))); typedef __bf16 bf16x2_t __attribute__((ext_vector_type(2)));
__device__ __forceinline__ unsigned cvtpk(float lo, float hi) { f32x2_t v = {lo, hi}; bf16x2_t b = __builtin_convertvector(v, bf16x2_t); return __builtin_bit_cast(unsigned, b); }
__device__ __forceinline__ int swap32_add(int v) { auto rr = __builtin_amdgcn_permlane32_swap((unsigned)v, (unsigned)v, false, false); return (int)(rr[0] + rr[1]); }
__device__ __forceinline__ unsigned swap32_or(unsigned v) { auto rr = __builtin_amdgcn_permlane32_swap(v, v, false, false); return rr[0] | rr[1]; }
__device__ __forceinline__ float swap32_max(float v) { auto rr = __builtin_amdgcn_permlane32_swap(__float_as_uint(v), __float_as_uint(v), false, false); return fmaxf(__uint_as_float(rr[0]), __uint_as_float(rr[1])); }
__device__ __forceinline__ float swap32_addf(float v) { auto rr = __builtin_amdgcn_permlane32_swap(__float_as_uint(v), __float_as_uint(v), false, false); return __uint_as_float(rr[0]) + __uint_as_float(rr[1]); }
__device__ __forceinline__ int wave_sum_dpp(int v) {
    v += __builtin_amdgcn_update_dpp(0, v, 0x111, 0xf, 0xf, false);
    v += __builtin_amdgcn_update_dpp(0, v, 0x112, 0xf, 0xf, false);
    v += __builtin_amdgcn_update_dpp(0, v, 0x114, 0xf, 0xf, false);
    v += __builtin_amdgcn_update_dpp(0, v, 0x118, 0xf, 0xf, false);
    v += __builtin_amdgcn_update_dpp(0, v, 0x142, 0xa, 0xf, false);
    v += __builtin_amdgcn_update_dpp(0, v, 0x143, 0xc, 0xf, false);
    return __builtin_amdgcn_readlane(v, 63);
}
template <int K> __device__ __forceinline__ unsigned swz_xor_u(unsigned v) { return (unsigned)__builtin_amdgcn_ds_swizzle((int)v, (K << 10) | 0x1F); }
__device__ __forceinline__ unsigned wave_min_u(unsigned v) { v = min(v, swz_xor_u<1>(v)); v = min(v, swz_xor_u<2>(v)); v = min(v, swz_xor_u<4>(v)); v = min(v, swz_xor_u<8>(v)); v = min(v, swz_xor_u<16>(v));
    auto rr = __builtin_amdgcn_permlane32_swap(v, v, false, false); return (unsigned)__builtin_amdgcn_readfirstlane((int)min(rr[0], rr[1])); }
__device__ __forceinline__ unsigned wave_max_u(unsigned v) { v = max(v, swz_xor_u<1>(v)); v = max(v, swz_xor_u<2>(v)); v = max(v, swz_xor_u<4>(v)); v = max(v, swz_xor_u<8>(v)); v = max(v, swz_xor_u<16>(v));
    auto rr = __builtin_amdgcn_permlane32_swap(v, v, false, false); return (unsigned)__builtin_amdgcn_readfirstlane((int)max(rr[0], rr[1])); }
__device__ __forceinline__ s16x4_t tr_read(const LAS unsigned char* p) { typedef short v4i16_t __attribute__((ext_vector_type(4))); return __builtin_bit_cast(s16x4_t, __builtin_amdgcn_ds_read_tr16_b64_v4i16((LAS v4i16_t*)p)); }
constexpr int AT_QIROW = 528, AT_KROW = 144, AT_VROW = 192, AT_GTM = 0, AT_KT = AT_GTM + 16384, AT_VT = AT_KT + 2 * 64 * AT_KROW, AT_QL = AT_VT + 2 * 64 * AT_VROW,
              AT_LDS = AT_QL + 512 * AT_KROW,
              AT_QI = 16384, AT_WI = AT_QI + 64 * AT_QIROW, AT_RD = AT_WI + 1024, AT_RDROW = 521, AT_P1END = AT_RD + 32 * AT_RDROW * 4;
static_assert(AT_LDS <= 143360 && AT_P1END <= 143360, "attention LDS");
static_assert(AT_LDS <= 143360, "attention LDS");
#define AT_BAR() do { asm volatile("s_waitcnt lgkmcnt(0)" ::: "memory"); __builtin_amdgcn_s_barrier(); asm volatile("" ::: "memory"); } while (0)
__device__ __forceinline__ void attn_unit(LAS unsigned char* lds, gcb16 P, gb16 AO, int b, int c, int wave_s) {
    gcb16 Pb = P + (size_t)b * S * PC;
    const int nkb = 2 * (c + 1);
    LAS unsigned* GTM = (LAS unsigned*)(lds + AT_GTM); LAS unsigned* RD = (LAS unsigned*)(lds + AT_RD); LAS float* WI = (LAS float*)(lds + AT_WI);
    AT_BAR();
    {
    const int lane = lane_id_here(), tid = wave_s * 64 + lane, n = lane & 31, h = lane >> 5;
    if (c < 4) {
        for (int e = tid; e < 64 * 64; e += 512) GTM[e] = 0xffffffffu;
    } else {
        { const int row = tid >> 3, pc = tid & 7; const GAS u32x4* src = (const GAS u32x4*)(Pb + (size_t)(c * 64 + row) * PC + PC_QI + pc * 32);
#pragma unroll
          for (int i = 0; i < 4; ++i) *(LAS u32x4*)(lds + AT_QI + row * AT_QIROW + pc * 64 + i * 16) = src[i];
          if (tid < 256) WI[tid] = bf2f(Pb[(size_t)(c * 64 + (tid >> 2)) * PC + PC_WI + (tid & 3)]); }
        AT_BAR();
        for (int rd = 0; rd < 2; ++rd) {
            const int qt = 32 * rd + n; int hq = 4 * h; asm volatile("" : "+v"(hq));
            unsigned sc[8][16];
            bf16x8_t kfn[4]; gcb16 kpn = Pb + (size_t)(wave_s * 32 + n) * PC + PC_KI + 8 * h;
            if (wave_s < nkb) {
#pragma unroll
                for (int s = 0; s < 4; ++s) kfn[s] = *(const GAS bf16x8_t*)(kpn + 16 * s); }
#pragma unroll
            for (int kbi = 0; kbi < 8; ++kbi) {
                const int kb = wave_s + 8 * kbi;
                if (kb < nkb) {
                    bf16x8_t kf[4];
#pragma unroll
                    for (int s = 0; s < 4; ++s) kf[s] = kfn[s];
                    kpn += (size_t)256 * PC; asm volatile("" : "+v"(kpn));
                    if (kb + 8 < nkb) {
#pragma unroll
                        for (int s = 0; s < 4; ++s) kfn[s] = *(const GAS bf16x8_t*)(kpn + 16 * s); }
                    float score[16];
#pragma unroll
                    for (int r = 0; r < 16; ++r) score[r] = 0.f;
#pragma unroll
                    for (int hh = 0; hh < 4; ++hh) { f32x16_t acc;
#pragma unroll
                        for (int r = 0; r < 16; ++r) acc[r] = 0.f;
#pragma unroll
                        for (int s = 0; s < 4; ++s) { const bf16x8_t qf = *(const LAS bf16x8_t*)(lds + AT_QI + qt * AT_QIROW + (hh * 64 + 16 * s + 8 * h) * 2); acc = MFMA32(kf[s], qf, acc); }
                        const float wv = WI[qt * 4 + hh];
#pragma unroll
                        for (int r = 0; r < 16; ++r) score[r] += wv * fmaxf(acc[r], 0.f); }
#pragma unroll
                    for (int r = 0; r < 16; ++r) sc[kbi][r] = (sortable(score[r]) & 0xfffff800u) | (unsigned)((2047 - kb * 32 - ((r & 3) + 8 * (r >> 2))) - hq);
                } else {
#pragma unroll
                    for (int r = 0; r < 16; ++r) sc[kbi][r] = 0u;
                }
            }
            const int nv = nkb >> 1;
            unsigned kv[4][32];
#pragma unroll
            for (int p = 0; p < 4; ++p) {
                AT_BAR();
#pragma unroll
                for (int q2 = 0; q2 < 2; ++q2) { const int kbi = 2 * p + q2, kb = wave_s + 8 * kbi;
                    if (kb < nkb) {
#pragma unroll
                        for (int r = 0; r < 16; ++r) RD[n * AT_RDROW + (wave_s + 8 * q2) * 32 + (r & 3) + 8 * (r >> 2) + 4 * h] = sc[kbi][r]; } }
                AT_BAR();
#pragma unroll
                for (int j = 0; j < 4; ++j)
#pragma unroll
                    for (int i2 = 0; i2 < 8; ++i2) kv[j][8 * p + i2] = (8 * p + i2 < nv) ? RD[(8 * j + wave_s) * AT_RDROW + lane + 64 * i2] : 0u;
            }
#pragma unroll
            for (int j = 0; j < 4; ++j) {
                unsigned mn = 0xffffffffu, mx = 0u;
#pragma unroll
                for (int i = 0; i < 32; ++i) if (i < nv) { mn = min(mn, kv[j][i]); mx = max(mx, kv[j][i]); }
                unsigned lo_u = wave_min_u(mn), hi_u = wave_max_u(mx); hi_u = hi_u == 0xffffffffu ? hi_u : hi_u + 1u;
                int c_lo = 32 * nkb, c_hi = 0;
                for (int iter = 0; iter < 400 && c_lo != 256 && hi_u - lo_u > 1u; ++iter) {
                    unsigned cand;
                    const float fl = unsortable(lo_u), fh = unsortable(hi_u);
                    const bool plateau = lo_u >= 0x80000000u && hi_u <= 0x80000800u;
                    if (iter == 0 && lo_u < 0x80000800u && hi_u > 0x80000800u) cand = 0x80000800u;
                    else if (iter == 1 && lo_u < 0x80000000u && hi_u > 0x80000000u && hi_u <= 0x80000800u) cand = 0x80000000u;
                    else if (plateau || (iter & 7) == 7 || (iter > 24 && (iter & 1))) cand = lo_u + ((hi_u - lo_u) >> 1);
                    else if (iter < 5 || (iter & 1)) cand = sortable(0.5f * fl + 0.5f * fh);
                    else cand = sortable(fl + (fh - fl) * (((float)(c_lo - 256) + 0.5f) * __builtin_amdgcn_rcpf((float)(c_lo - c_hi))));
                    cand = max(cand, lo_u + 1u); cand = min(cand, hi_u - 1u);
                    cand = (unsigned)__builtin_amdgcn_readfirstlane((int)cand);
                    unsigned ca = 0u, cb = 0u;
#pragma unroll
                    for (int i = 0; i < 32; i += 8) if (i < nv) {
                        unsigned long long m0, m1, m2, m3, m4, m5, m6, m7;
                        asm volatile("v_cmp_ge_u32_e64 %2, %10, %18\n\tv_cmp_ge_u32_e64 %3, %11, %18\n\tv_cmp_ge_u32_e64 %4, %12, %18\n\tv_cmp_ge_u32_e64 %5, %13, %18\n\t"
                                     "v_cmp_ge_u32_e64 %6, %14, %18\n\tv_cmp_ge_u32_e64 %7, %15, %18\n\tv_cmp_ge_u32_e64 %8, %16, %18\n\tv_cmp_ge_u32_e64 %9, %17, %18\n\t"
                                     "v_addc_co_u32_e64 %0, %2, %0, 0, %2\n\tv_addc_co_u32_e64 %1, %3, %1, 0, %3\n\tv_addc_co_u32_e64 %0, %4, %0, 0, %4\n\tv_addc_co_u32_e64 %1, %5, %1, 0, %5\n\t"
                                     "v_addc_co_u32_e64 %0, %6, %0, 0, %6\n\tv_addc_co_u32_e64 %1, %7, %1, 0, %7\n\tv_addc_co_u32_e64 %0, %8, %0, 0, %8\n\tv_addc_co_u32_e64 %1, %9, %1, 0, %9"
                                     : "+v"(ca), "+v"(cb), "=&s"(m0), "=&s"(m1), "=&s"(m2), "=&s"(m3), "=&s"(m4), "=&s"(m5), "=&s"(m6), "=&s"(m7)
                                     : "v"(kv[j][i]), "v"(kv[j][i + 1]), "v"(kv[j][i + 2]), "v"(kv[j][i + 3]), "v"(kv[j][i + 4]), "v"(kv[j][i + 5]), "v"(kv[j][i + 6]), "v"(kv[j][i + 7]), "v"(cand));
                    }
                    const int cnt = wave_sum_dpp((int)(ca + cb));
                    if (cnt >= 256) { lo_u = cand; c_lo = cnt; } else { hi_u = cand; c_hi = cnt; }
                }
                const int qrow = (32 * rd + 8 * j + wave_s) * 64;
#pragma unroll
                for (int i = 0; i < 32; ++i) if (i < nv) { const unsigned long long mm = __ballot(kv[j][i] >= lo_u);
                    if (lane == 0) { GTM[qrow + 2 * i] = (unsigned)mm; GTM[qrow + 2 * i + 1] = (unsigned)(mm >> 32); } }
            }
        }
        AT_BAR();
    }
    }
    const int lane = lane_id_here(), tid = wave_s * 64 + lane, n = lane & 31, h = lane >> 5;
    const float C2 = 0.125f * 1.4426950408889634f;
    bf16x8_t qfe[2]; float nsl16[2], m_run[2], l_run[2]; int tql[2]; f32x16_t O[2][2];
#pragma unroll
    for (int i = 0; i < 8; ++i) { const int e = tid + 512 * i, R = e >> 3, pc = e & 7;
        *(LAS u32x4*)(lds + AT_QL + R * AT_KROW + pc * 16) = *(const GAS u32x4*)(Pb + (size_t)(c * 64 + (R >> 3)) * PC + PC_Q + (R & 7) * 64 + pc * 8); }
#pragma unroll
    for (int rb = 0; rb < 2; ++rb) { const int R = 64 * wave_s + 32 * rb + n, tl = R >> 3, hd = R & 7; tql[rb] = tl;
        { int cq = c; asm volatile("" : "+s"(cq)); const float sl8 = exp2f((float)(2 - hd));
          const unsigned q0 = __float_as_uint(64.f * sl8) >> 16, q1 = __float_as_uint(sl8) >> 16, q2 = __float_as_uint(-64.f * sl8 * (float)cq) >> 16, q3 = __float_as_uint(-sl8 * (float)tl) >> 16;
          const u32x4 qe = {h == 0 ? (q0 | (q1 << 16)) : 0u, h == 0 ? (q2 | (q3 << 16)) : 0u, 0u, 0u}; qfe[rb] = __builtin_bit_cast(bf16x8_t, qe); nsl16[rb] = -2.f * sl8; }
        m_run[rb] = -1.0e30f; l_run[rb] = 0.f;
#pragma unroll
        for (int db = 0; db < 2; ++db)
#pragma unroll
            for (int r = 0; r < 16; ++r) O[rb][db][r] = 0.f; }
    const int skey = tid >> 3, sch = tid & 7;
    u32x4 stK, stV;
    { gcb16 kp = Pb + (size_t)skey * PC + PC_K + sch * 8; stK = *(const GAS u32x4*)kp; stV = *(const GAS u32x4*)(kp + 64); }
    *(LAS u32x4*)(lds + AT_KT + skey * AT_KROW + sch * 16) = stK; *(LAS u32x4*)(lds + AT_VT + skey * AT_VROW + sch * 16) = stV;
    AT_BAR();
    const int gl = lane >> 4, i16 = lane & 15, trq = i16 >> 2, trp = i16 & 3;
    for (int jt = 0; jt <= c; ++jt) {
        const int buf = jt & 1;
        if (jt < c) { gcb16 kp = Pb + (size_t)((jt + 1) * 64 + skey) * PC + PC_K + sch * 8; stK = *(const GAS u32x4*)kp; stV = *(const GAS u32x4*)(kp + 64); }
        const LAS unsigned char* KT = lds + AT_KT + buf * 64 * AT_KROW; const LAS unsigned char* VT = lds + AT_VT + buf * 64 * AT_VROW;
#pragma unroll 1
        for (int kb2 = 0; kb2 < 2; ++kb2) {
            bf16x8_t kf[4], vf[2][2];
            const u32x4 ke = {h == 0 ? ((__float_as_uint((float)jt) >> 16) | (__float_as_uint((float)(32 * kb2 + n)) & 0xffff0000u)) : 0u, h == 0 ? 0x3f803f80u : 0u, 0u, 0u};
            const bf16x8_t kfe = __builtin_bit_cast(bf16x8_t, ke);
#pragma unroll
            for (int s = 0; s < 4; ++s) kf[s] = *(const LAS bf16x8_t*)(KT + (32 * kb2 + n) * AT_KROW + (16 * s + 8 * h) * 2);
#pragma unroll
            for (int db = 0; db < 2; ++db)
#pragma unroll
                for (int s2 = 0; s2 < 2; ++s2) { const LAS unsigned char* vb = VT + (32 * kb2 + 16 * s2 + 4 * h + trq) * AT_VROW + (32 * db + 16 * (gl & 1) + 4 * trp) * 2;
                    const s16x4_t lo = tr_read(vb), hi = tr_read(vb + 8 * AT_VROW);
                    vf[db][s2] = (bf16x8_t){lo[0], lo[1], lo[2], lo[3], hi[0], hi[1], hi[2], hi[3]}; }
#pragma unroll
            for (int rb = 0; rb < 2; ++rb) {
                f32x16_t sacc;
#pragma unroll
                for (int r = 0; r < 16; ++r) sacc[r] = 0.f;
#pragma unroll
                for (int s = 0; s < 4; ++s) { const bf16x8_t qfr = *(const LAS bf16x8_t*)(lds + AT_QL + (64 * wave_s + 32 * rb + n) * AT_KROW + (16 * s + 8 * h) * 2); sacc = MFMA32(kf[s], qfr, sacc); }
                sacc = MFMA32(kfe, qfe[rb], sacc);
                const unsigned mw = GTM[tql[rb] * 64 + 2 * jt + kb2] >> (4 * h);
                if (jt == c) {
                    const float fd = (float)(32 * kb2 + 4 * h - tql[rb]);
#pragma unroll
                    for (int r = 0; r < 16; ++r) sacc[r] += nsl16[rb] * fmaxf(fd + (float)((r & 3) + 8 * (r >> 2)), 0.f); }
                float sv[16]; float mt = -INFINITY;
#pragma unroll
                for (int r = 0; r < 16; ++r) { const int sh = (r & 3) + 8 * (r >> 2);
                    const int tmask = __builtin_amdgcn_sbfe((int)mw, sh, 1);
                    sv[r] = __uint_as_float((__float_as_uint(sacc[r]) & (unsigned)tmask) | (0xff800000u & ~(unsigned)tmask)); mt = fmaxf(mt, sv[r]); }
                mt = swap32_max(mt) * C2;
                if (__any(mt > m_run[rb] + 8.0f)) { const float mn = fmaxf(m_run[rb], mt), al = __builtin_amdgcn_exp2f(m_run[rb] - mn); m_run[rb] = mn; l_run[rb] *= al;
#pragma unroll
                    for (int db = 0; db < 2; ++db)
#pragma unroll
                        for (int r = 0; r < 16; ++r) O[rb][db][r] *= al; }
                float ps = 0.f; unsigned pw[8]; const float nm = -m_run[rb];
#pragma unroll
                for (int r = 0; r < 16; r += 2) { const float p0 = __builtin_amdgcn_exp2f(fmaf(sv[r], C2, nm)), p1 = __builtin_amdgcn_exp2f(fmaf(sv[r + 1], C2, nm)); ps += p0 + p1; pw[r >> 1] = cvtpk(p0, p1); }
                l_run[rb] += ps;
#pragma unroll
                for (int s2 = 0; s2 < 2; ++s2) { const u32x4 pk = {pw[4 * s2], pw[4 * s2 + 1], pw[4 * s2 + 2], pw[4 * s2 + 3]}; const bf16x8_t pf = __builtin_bit_cast(bf16x8_t, pk);
#pragma unroll
                    for (int db = 0; db < 2; ++db) O[rb][db] = MFMA32(vf[db][s2], pf, O[rb][db]); }
            }
        }
        if (jt < c) { const int nb_ = buf ^ 1; *(LAS u32x4*)(lds + AT_KT + nb_ * 64 * AT_KROW + skey * AT_KROW + sch * 16) = stK; *(LAS u32x4*)(lds + AT_VT + nb_ * 64 * AT_VROW + skey * AT_VROW + sch * 16) = stV; }
        AT_BAR();
    }
#pragma unroll
    for (int rb = 0; rb < 2; ++rb) { const float inv = 1.0f / swap32_addf(l_run[rb]); const int R = 64 * wave_s + 32 * rb + n, tl = R >> 3, hd = R & 7;
        gb16 op = AO + (size_t)(b * S + c * 64 + tl) * 512 + hd * 64 + 4 * h;
#pragma unroll
        for (int db = 0; db < 2; ++db)
#pragma unroll
            for (int g4 = 0; g4 < 4; ++g4) { u32x2v w; w.x = cvtpk(O[rb][db][4 * g4] * inv, O[rb][db][4 * g4 + 1] * inv); w.y = cvtpk(O[rb][db][4 * g4 + 2] * inv, O[rb][db][4 * g4 + 3] * inv);
                *(GAS u32x2v*)(op + 32 * db + 8 * g4) = w; } }
}


struct SrcId { __device__ int operator()(int r) const { return r; } };
struct SrcWin { __device__ int operator()(int r) const { return refcol_of(r); } };
template <int HALFN> struct SrcPair { __device__ int operator()(int r) const { const int t = r >> 8, i = r & 255; return i < 128 ? 128 * t + i : HALFN + 128 * t + (i - 128); } };
template <class SC>
__device__ __forceinline__ void transpose_item(gcf32 W, int K, int N, gb16 WT, SC sc, LAS float* scr  , int item, int lane) {
    const int nk = K / 64, kb = item % nk, nb = item / nk, k0 = 64 * kb, n0 = 64 * nb;
    const int c4 = 4 * (lane & 15), col = sc(n0 + c4);
    f32x4 tv[16];
#pragma unroll
    for (int i = 0; i < 16; ++i) { const int kk = 4 * i + (lane >> 4); tv[i] = (f32x4){0.f, 0.f, 0.f, 0.f}; if (col >= 0) tv[i] = *(const GAS f32x4*)(W + (size_t)(k0 + kk) * N + col); }
#pragma unroll
    for (int i = 0; i < 16; ++i) { const int kk = 4 * i + (lane >> 4); LAS float* d = scr + kk * 65 + c4; d[0] = tv[i][0]; d[1] = tv[i][1]; d[2] = tv[i][2]; d[3] = tv[i][3]; }
    asm volatile("s_waitcnt lgkmcnt(0)" ::: "memory");
    const int c = lane & 7;
#pragma unroll
    for (int j = 0; j < 8; ++j) { const int n = (lane >> 3) + 8 * j; const LAS float* s = scr + (8 * c) * 65 + n;
        u32x4 o; o.x = pg8::cvt_pk_bf16(s[0 * 65], s[1 * 65]); o.y = pg8::cvt_pk_bf16(s[2 * 65], s[3 * 65]); o.z = pg8::cvt_pk_bf16(s[4 * 65], s[5 * 65]); o.w = pg8::cvt_pk_bf16(s[6 * 65], s[7 * 65]);
        *(GAS u32x4*)(WT + (size_t)(n0 + n) * K + k0 + 8 * c) = o; }
    asm volatile("s_waitcnt lgkmcnt(0)" ::: "memory");
}
template <int I> __device__ __forceinline__ gcf32 KIN();
__device__ __forceinline__ void ph_weights(gu8 ws, LAS float* scr, int gw, int lane) {
    constexpr int I_WIN = 16 * (PC / 64), I_WFI = 16 * (2 * DFF / 64), I_WFO = (DFF / 64) * (D / 64), I_WO = 16 * (D / 64), I_WC = 4 * (D / 64), I_WGLU = 4 * (2 * D / 64), I_WAO = 8 * (D / 64);
    constexpr int I_WMOD = 16 * (6 * D / 64), I_LAYER = I_WMOD + I_WIN + I_WFI + I_WFO + I_WO + I_WC + I_WGLU + I_WAO;
    for (int it = gw; it < NL * I_LAYER; it += NGW) {
        const int l = it / I_LAYER; int r = it % I_LAYER; gu8 wl = ws + WS_W + (size_t)l * WS_W_LAYER;
        if (r < I_WMOD) { transpose_item(KIN<2>() + (size_t)l * D * 6 * D, D, 6 * D, (gb16)(ws + WS_WMODT) + (size_t)l * 6 * D * D, SrcId{}, scr, r, lane); continue; } r -= I_WMOD;
        if (r < I_WIN) { transpose_item(KIN<5>() + (size_t)l * D * DIN, D, DIN, (gb16)(wl + WO_WIN), SrcWin{}, scr, r, lane); continue; } r -= I_WIN;
        if (r < I_WFI) { transpose_item(KIN<21>() + (size_t)l * D * 2 * DFF, D, 2 * DFF, (gb16)(wl + WO_WFI), SrcPair<DFF>{}, scr, r, lane); continue; } r -= I_WFI;
        if (r < I_WFO) { transpose_item(KIN<22>() + (size_t)l * DFF * D, DFF, D, (gb16)(wl + WO_WFO), SrcId{}, scr, r, lane); continue; } r -= I_WFO;
        if (r < I_WO) { transpose_item(KIN<19>() + (size_t)l * D * D, D, D, (gb16)(wl + WO_WO), SrcId{}, scr, r, lane); continue; } r -= I_WO;
        if (r < I_WC) { transpose_item(KIN<8>() + (size_t)l * 256 * D, 256, D, (gb16)(wl + WO_WC), SrcId{}, scr, r, lane); continue; } r -= I_WC;
        if (r < I_WGLU) { transpose_item(KIN<17>() + (size_t)l * 256 * 2 * D, 256, 2 * D, (gb16)(wl + WO_WGLU), SrcPair<D>{}, scr, r, lane); continue; } r -= I_WGLU;
        transpose_item(KIN<18>() + (size_t)l * 512 * D, 512, D, (gb16)(wl + WO_WAO), SrcId{}, scr, r, lane);
    }
}
template <class Epi>
__device__ __forceinline__ void run_gemm(LAS unsigned char* ring, gcb16 A, int lda, gcb16 Bt, int N, int K, const Epi& E, int wave_s) {
    pg8::Gemm g{(const bf16_t*)A, (const bf16_t*)Bt, M, N, K, lda}; const int bx_ = (int)blockIdx.x; __builtin_assume(bx_ >= 0 && bx_ < GRID); pg8::StaticOrder S; S.init(M, N, GRID, bx_);
    pg8::gemm_phase<Epi, pg8::StaticOrder, true, true>(ring, g, S, E, wave_s);
}
struct PairedOrder : pg8::StaticOrder {
    __device__ __forceinline__ bool next(int j, Unit& u) const { Unit v; if (!pg8::StaticOrder::next(j >> 1, v)) return false; u.pm = v.pm; u.pn = 2 * v.pn + (j & 1); return true; }
};
template <class Epi>
__device__ __forceinline__ void run_gemm_paired(LAS unsigned char* ring, gcb16 A, int lda, gcb16 Bt, int K, const Epi& E, int wave_s) {
    pg8::Gemm g{(const bf16_t*)A, (const bf16_t*)Bt, M, 2 * D, K, lda}; const int bx_ = (int)blockIdx.x; __builtin_assume(bx_ >= 0 && bx_ < GRID); PairedOrder S; S.init(M, D, GRID, bx_);
    pg8::gemm_phase<Epi, PairedOrder, true, true>(ring, g, S, E, wave_s);
}
template <class Epi>
__device__ __forceinline__ void run_gemm16(LAS unsigned char* ring, gcb16 A, gcb16 Bt, int N, const Epi& E, int cidx, int wave_s) {
    if (cidx < 0 || cidx >= N / 256) return;
    pg8::Gemm g{(const bf16_t*)A, (const bf16_t*)Bt, 256, N, D, D}; pg8::StaticOrder S; S.init(256, N, GRID, cidx);
    pg8::gemm_phase<Epi, pg8::StaticOrder, true, true>(ring, g, S, E, wave_s);
}

template <int I> __device__ __forceinline__ gcf32 KIN() {
    auto kp = __builtin_amdgcn_kernarg_segment_ptr(); unsigned long long v;
    asm volatile("s_load_dwordx2 %0, %1, %2\n\ts_waitcnt lgkmcnt(0)" : "=s"(v) : "s"(kp), "i"(8 * I) : "memory");
    return (gcf32)v;
}
__global__ void __launch_bounds__(NTHREADS, 2) mk_fwd(Args a) {
    extern __shared__ __attribute__((aligned(16))) unsigned char lds_raw[];
    LAS unsigned char* ring = (LAS unsigned char*)lds_raw;
    volatile LAS unsigned* MISC = (volatile LAS unsigned*)((LAS unsigned char*)lds_raw + MISC_OFF);
    const int wave_s = __builtin_amdgcn_readfirstlane(threadIdx.x >> 6);
    { const unsigned bx_ = blockIdx.x; __builtin_assume(bx_ < GRID); } __builtin_assume(wave_s >= 0 && wave_s < NWAVES);
#define IDS const int lane = lane_id_here(), gw = blockIdx.x * NWAVES + wave_s; __builtin_assume(gw >= 0 && gw < NGW); __builtin_assume(lane >= 0 && lane < 64); (void)lane; (void)gw;
    if (wave_s == 0) { const int l0 = lane_id_here(); if (l0 < 32) MISC[l0] = 0u; }
    __syncthreads();
    gu8 ws = (gu8)KIN<25>();
    XcdBarrier bar = xcd_barrier_post((unsigned*)(ws + WS_CTL) + 1024, MISC + 8, wave_s);
#define XB_ ((gb16)KIN<24>())
#define X_ ((gf32)(ws + WS_P + 176 * MiB))
#define MOD_ ((gf32)(ws + WS_MOD))
#define H_ ((gb16)(ws + WS_H))
#define CONVA_ ((gb16)(ws + WS_CONVA))
#define Z_ ((gb16)(ws + WS_Z))
#define AO_ ((gb16)(ws + WS_AO))
#define P_ ((gb16)(ws + WS_P))
#define ACT_ ((gb16)(ws + WS_P))
#define WT_(l, off) ((gcb16)(ws + WS_W + (size_t)(l) * WS_W_LAYER + (off)))
#define A16_(i) ((gb16)(ws + WS_A16) + (size_t)(i) * 256 * D)
    { IDS; ph_a16(KIN<1>(), A16_(0), (gu64)(ws + WS_SSQ), gw, lane); }
    { IDS; ph_ssm_params(KIN<9>(), KIN<10>(), KIN<11>(), KIN<12>(), KIN<13>(), (gf32)(ws + WS_SSMP), (gf32)(ws + WS_AP), gw, lane); }
    { IDS; ph_ssm_kd(KIN<9>(), KIN<10>(), KIN<11>(), KIN<12>(), KIN<13>(), KIN<14>(), KIN<15>(), (gf32)(ws + WS_KD), (LAS float*)(ring + wave_s * 16640), gw, lane); }
    { IDS; ph_weights(ws, (LAS float*)(ring + wave_s * 16640), gw, lane); }
    xcd_barrier(bar, wave_s);
    { const int bxv = (int)blockIdx.x;
      for (int l = 0; l < NL; ++l) run_gemm16(ring, A16_(0), (gcb16)(ws + WS_WMODT) + (size_t)l * 6 * D * D, 6 * D, EpiMod{MOD_ + (size_t)l * NB * 6 * D, KIN<3>() + l * 6 * D, A16_(1 + 2 * l), A16_(2 + 2 * l)}, bxv - 128 * l, wave_s); }
    { IDS; ph_ssm_frags(KIN<14>(), KIN<15>(), (gcf32)(ws + WS_SSMP), (gcf32)(ws + WS_AP), (gcf32)(ws + WS_KD), ws + WS_SSMT, gw, lane); }
    xcd_barrier(bar, wave_s);
    { const int bxv = (int)blockIdx.x;
      for (int l = 0; l < NL; ++l) {
          run_gemm16(ring, A16_(1 + 2 * l), WT_(l, WO_WIN), PC, EpiBias{(gf32)(ws + WS_BIAS) + (size_t)l * BIAS_LAYER, PC, KIN<6>() + l * 3 * D, PC_G}, bxv - 128 * l, wave_s);
          run_gemm16(ring, A16_(2 + 2 * l), WT_(l, WO_WFI), 2 * DFF, EpiBias{(gf32)(ws + WS_BIAS) + (size_t)l * BIAS_LAYER + NB * PC, 2 * DFF, (gcf32)nullptr, 0}, bxv - 128 * l - 64, wave_s); } }
    { const int bxv = (int)blockIdx.x, q4 = bxv >> 6, r64 = bxv & 63, ng = (q4 & 1) ? 22 : 20;
      if (r64 >= ng) { const int rank = q4 * 64 - (q4 >> 1) * 42 - (q4 & 1) * 20 + (r64 - ng); const int lane = lane_id_here(); ph_h0(KIN<0>(), KIN<4>(), MOD_, D, H_, (gu64)(ws + WS_SSQ), rank * NWAVES + wave_s, 172 * NWAVES, lane); } }
    xcd_barrier(bar, wave_s);
#define SSQ_(i) ((gu64)(ws + WS_SSQ) + (size_t)(i) * M)
#define MODL_(l) (MOD_ + (size_t)(l) * NB * 6 * D)
#define BIAS_(l) ((gcf32)(ws + WS_BIAS) + (size_t)(l) * BIAS_LAYER)
    for (int l = 0; l < NL; ++l) {
        run_gemm(ring, H_, D, WT_(l, WO_WIN), PC, D, EpiInproj{P_, BIAS_(l), SSQ_(2 * l)}, wave_s);
        xcd_barrier(bar, wave_s);
        { IDS; ph_conv(P_, KIN<7>() + l * 768, CONVA_, gw, lane); }
        { const int v = (blockIdx.x & 7) * 32 + (blockIdx.x >> 3);
          ssm_fast_item(ring, P_, ws + WS_SSMT + (size_t)l * SSMT_LAYER, (gcf32)(ws + WS_AP) + (size_t)l * 1024 * 65 * 2, KIN<16>() + l * 256, Z_, v >> 4, v & 15, wave_s);
          attn_unit(ring, P_, AO_, v >> 4, 31 - (v & 15), wave_s); attn_unit(ring, P_, AO_, v >> 4, v & 15, wave_s); }
        xcd_barrier(bar, wave_s);
        run_gemm_paired(ring, Z_, 256, WT_(l, WO_WGLU), 256, EpiGlu{P_}, wave_s);
        run_gemm(ring, CONVA_, 256, WT_(l, WO_WC), D, 256, EpiMixAcc{P_, PC_G}, wave_s);
        run_gemm(ring, AO_, 512, WT_(l, WO_WAO), D, 512, EpiMixAcc{P_, PC_G + 2 * D}, wave_s);
        xcd_barrier(bar, wave_s);
        run_gemm(ring, P_, PC, WT_(l, WO_WO), D, D, EpiRes{(l == 0) ? KIN<0>() : (gcf32)nullptr, (l == 0) ? (gcb16)nullptr : (gcb16)XB_, (gf32)nullptr, XB_, MODL_(l) + 2 * D, SSQ_(2 * l + 1), H_, KIN<20>() + l * D, MODL_(l) + 4 * D}, wave_s);
        xcd_barrier(bar, wave_s);
        run_gemm(ring, H_, D, WT_(l, WO_WFI), 2 * DFF, D, EpiFfnIn{ACT_, BIAS_(l) + NB * PC, SSQ_(2 * l + 1)}, wave_s);
        xcd_barrier(bar, wave_s);
        run_gemm(ring, ACT_, DFF, WT_(l, WO_WFO), D, DFF, EpiRes{(gcf32)nullptr, XB_, (l + 1 < NL) ? (gf32)nullptr : X_, (l + 1 < NL) ? XB_ : (gb16)nullptr, MODL_(l) + 5 * D, SSQ_(2 * l + 2), (l + 1 < NL) ? H_ : (gb16)nullptr, KIN<4>() + (l + 1 < NL ? (l + 1) * D : 0), MODL_(l + 1 < NL ? l + 1 : l) + D}, wave_s);
        xcd_barrier(bar, wave_s);
    }
    { IDS; ph_final_norm(X_, (gf32)KIN<24>(), KIN<23>(), SSQ_(2 * NL), gw, lane); }
}
}

extern "C" void kernel_launch(void* const* d_in, const int* in_sizes, int n_in, void* d_out, int out_size, void* d_ws, size_t ws_size, hipStream_t stream) {
    static int ok = 0;
    if (ok == 0) {
        int dev = 0, cus = 0;
        if (n_in != 24 || ws_size < WS_END || hipGetDevice(&dev) != hipSuccess || hipDeviceGetAttribute(&cus, hipDeviceAttributeMultiprocessorCount, dev) != hipSuccess || cus != GRID) {
            fprintf(stderr, "kernel_launch: unexpected configuration (n_in %d, ws %zu, CUs %d)\n", n_in, ws_size, cus); ok = -1; return; }
        if (hipFuncSetAttribute((const void*)mk_fwd, hipFuncAttributeMaxDynamicSharedMemorySize, LDS_BYTES) != hipSuccess) { fprintf(stderr, "kernel_launch: hipFuncSetAttribute failed\n"); ok = -1; return; }
        ok = 1;
    }
    if (ok < 0) return;
    (void)hipMemsetAsync((char*)d_ws + WS_CTL, 0, CTL_ZERO_BYTES, stream);
    Args a{};
    for (int i = 0; i < 24; ++i) a.in[i] = (const float*)d_in[i];
    a.out = (float*)d_out; a.ws = (unsigned char*)d_ws;
    hipLaunchKernelGGL(mk_fwd, dim3(GRID), dim3(NTHREADS), LDS_BYTES, stream, a);
}
```

```cpp
#include <hip/hip_runtime.h>
#include <stdint.h>
#include <math.h>
#include <stdio.h>

namespace {
constexpr int D = 1024, NB = 16, S = 2048, M = NB * S, NL = 2;
constexpr int DIN = 5060, PC = 5120, DFF = 2816;
constexpr int PC_CONV = 0, PC_SSM = 768, PC_Q = 1024, PC_K = 1536, PC_V = 1600, PC_KI = 1664, PC_WI = 1728, PC_QI = 1792, PC_G = 2048;

constexpr size_t MiB = 1u << 20;
constexpr size_t WS_CTL = 0, CTL_ZERO_BYTES = 64 * 1024;
constexpr size_t WS_CACT = 64 * 1024;
constexpr size_t WS_SSMP = 256 * 1024;
constexpr int SSMP_LAYER = 2048 + 32768;
constexpr size_t WS_MOD = 1 * MiB;
constexpr size_t WS_H = 2 * MiB;
constexpr size_t WS_CONVA = WS_H;
constexpr size_t WS_Z = WS_H + 16 * MiB;
constexpr size_t WS_AO = WS_H + 32 * MiB;
constexpr size_t WS_P = 66 * MiB;
constexpr size_t WS_W = 386 * MiB, WS_W_LAYER = 32 * MiB;
constexpr size_t WO_WIN = 0, WO_WFI = 10 * MiB, WO_WFO = 21 * MiB, WO_WO = 26 * MiB + 512 * 1024, WO_WC = 28 * MiB + 512 * 1024, WO_WGLU = 29 * MiB, WO_WAO = 30 * MiB;
constexpr size_t WS_AP = 450 * MiB;
constexpr size_t WS_KD = 452 * MiB;
constexpr size_t WS_SSMT = 454 * MiB, SSMT_LAYER = 10 * MiB;
constexpr int SSM_NFRAG = 65 + 256 + 256;
constexpr size_t WS_BIAS = 475 * MiB;
constexpr int BIAS_LAYER = NB * PC + NB * 2 * DFF;
constexpr size_t WS_WMODT = 477 * MiB;
constexpr size_t WS_A16 = 501 * MiB;
constexpr size_t WS_SSQ = 504 * MiB;
constexpr size_t WS_END = 506 * MiB;
static_assert(WS_AP + (size_t)NL * 1024 * 65 * 8 <= WS_KD && WS_KD + (size_t)NL * 16 * 64 * 256 * 4 <= WS_SSMT, "ws map");

#define GAS __attribute__((address_space(1)))
#define LAS __attribute__((address_space(3)))
typedef unsigned short bf16_t;
typedef float f32x2v __attribute__((ext_vector_type(2))); typedef float f32x4v __attribute__((ext_vector_type(4))); typedef unsigned u32x2v __attribute__((ext_vector_type(2))); typedef unsigned short u16x4v __attribute__((ext_vector_type(4)));
typedef GAS const float* gcf32; typedef GAS float* gf32; typedef GAS const bf16_t* gcb16; typedef GAS bf16_t* gb16; typedef GAS const unsigned char* gcu8; typedef GAS unsigned char* gu8;
__device__ __forceinline__ float bf2f(bf16_t v) { return __uint_as_float((unsigned)v << 16); }
__device__ __forceinline__ bf16_t f2bf(float f) { unsigned u = __float_as_uint(f); return (bf16_t)((u + 0x7fffu + ((u >> 16) & 1u)) >> 16); }
__device__ __forceinline__ float siluf_(float x) { return x / (1.f + __expf(-x)); }
__device__ __forceinline__ float gelu_tanh(float x) { const float u = 0.7978845608028654f * (x + 0.044715f * x * x * x); return 0.5f * x * (1.f + tanhf(u)); }
__device__ __forceinline__ int refcol_of(int c) {
    if (c < PC_KI) return c;
    if (c < PC_WI) return 1920 + (c - PC_KI);
    if (c < PC_WI + 4) return 1984 + (c - PC_WI);
    if (c < PC_QI) return -1;
    if (c < PC_G) return 1664 + (c - PC_QI);
    return 1988 + (c - PC_G);
}
constexpr int NWAVES = 8, NTHREADS = 512, GRID = 256, NGW = GRID * NWAVES;
constexpr int LDS_BYTES = 147456, MISC_OFF = 145408;
}
__device__ __forceinline__ int lane_id_here() { int l; asm volatile("v_mbcnt_lo_u32_b32 %0, -1, 0\n\tv_mbcnt_hi_u32_b32 %0, -1, %0" : "=v"(l)); return l; }
namespace pg8 {
#define PG8_LAS __attribute__((address_space(3)))
typedef unsigned short bf16_t;
typedef short bf16x8 __attribute__((ext_vector_type(8)));
typedef float f32x4 __attribute__((ext_vector_type(4)));
typedef unsigned u32x4 __attribute__((ext_vector_type(4)));
constexpr int BM = 256, BK = 64, HALF = 128, HTB = HALF * BK * 2  , STAGE_BYTES = 8 * HTB, NXCD = 8, WGM = 8;

__host__ __device__ __forceinline__ int lds_byte(int r, int c) { const int st = (r >> 4) * 2 + (c >> 5), rr = r & 15, cc = c & 31, ob = rr * 64 + cc * 2; return st * 1024 + (ob ^ (((ob >> 9) & 1) << 5)); }
__host__ __device__ __forceinline__ void stage_rc(int b, int& R, int& C) { const int st = b / 1024, sb = b % 1024, swz = sb ^ (((sb >> 9) & 1) << 5); R = (st >> 1) * 16 + swz / 64; C = (st & 1) * 32 + (swz % 64) / 2; }
__host__ __device__ __forceinline__ int perm32(int rho) { const int n = rho >> 4, i = rho & 15; return 8 * (i >> 2) + 4 * n + (i & 3); }

struct Unit { int pm, pn; };
struct Gemm { const bf16_t* A; const bf16_t* Bt; int M, N, K, lda; };

struct StaticOrder {
    int nM, nN, nwg, G, c;
    __host__ __device__ void init(int M, int N, int G_, int c_) { nM = M / BM; nN = N / BM; nwg = nM * nN; G = G_; c = c_; }
    __host__ __device__ bool next(int i, Unit& u) const {
        const long L = (long)i * G + c; if (L >= nwg) return false;
        int wgid = (int)L; { const int q = nwg / NXCD, r = nwg % NXCD, xcd = wgid % NXCD, off = wgid / NXCD; wgid = (xcd < r ? xcd * (q + 1) : r * (q + 1) + (xcd - r) * q) + off; }
        const int nig = WGM * nN, gid = wgid / nig, fm = gid * WGM, gsz = (nM - fm) < WGM ? (nM - fm) : WGM;
        u.pm = fm + ((wgid % nig) % gsz); u.pn = (wgid % nig) / gsz; return true;
    }
    __device__ __forceinline__ void a_ready(const Unit&) const {}
    __device__ __forceinline__ void done(const Unit&) const {}
};

__device__ __forceinline__ unsigned cvt_pk_bf16(float lo, float hi) { unsigned r; asm volatile("v_cvt_pk_bf16_f32 %0, %1, %2" : "=v"(r) : "v"(lo), "v"(hi)); return r; }
template <class Epi, class Sched, bool ALIGN_EPI = false, bool SP2 = false>
__device__ __forceinline__ void gemm_phase(PG8_LAS unsigned char* lds, const Gemm g, const Sched& S, const Epi& E, int wave_s) {
    int ws_ = wave_s; asm volatile("" : "+s"(ws_));
    const int tid = ws_ * 64 + lane_id_here(), wid = ws_,
              lane = tid & 63, wr = wid >> 2, wc = wid & 3, fr = lane & 15, fq = lane >> 4;
    const int K = g.K, nt = K / BK;
    unsigned voffA[2], voffB[2];
#pragma unroll
    for (int i = 0; i < 2; ++i) { int R, C; stage_rc(tid * 16 + i * 8192, R, C); const int Rb = Epi::PERM ? ((R & ~31) + perm32(R & 31)) : R;
        voffA[i] = (unsigned)(R * g.lda + C) * 2u; voffB[i] = (unsigned)(Rb * K + C) * 2u; }
    const size_t kstep = (size_t)(BK * 2);
    const size_t hstepB = (size_t)HALF * K * 2, hstepA = (size_t)HALF * g.lda * 2;
    const size_t tstepB = 2 * hstepB, tstepA = 2 * hstepA;
    const unsigned ldsw = (unsigned)wid * 1024u;
    const int aoff = lds_byte(wr * 64 + fr, fq * 8), boff = lds_byte(wc * 32 + fr, fq * 8);
#define PG8_SA(b, h) (((b) * 2 + (h)) * HTB)
#define PG8_SB(b, h) ((4 + (b) * 2 + (h)) * HTB)
#define PG8_STAGE(bufoff, gbase, voff) do { _Pragma("unroll") for (int _i = 0; _i < 2; ++_i) \
        __builtin_amdgcn_global_load_lds((const unsigned*)((const char*)(gbase) + (voff)[_i]), (PG8_LAS unsigned*)(lds + (bufoff) + ldsw + _i * 8192), 16, 0, 0); } while (0)
#define PG8_LDA(dst, b, h) do { _Pragma("unroll") for (int m = 0; m < 4; ++m) _Pragma("unroll") for (int k = 0; k < 2; ++k) dst[m][k] = *(const PG8_LAS bf16x8*)(lds + PG8_SA(b, h) + aoff + m * 2048 + k * 1024); } while (0)
#define PG8_LDB(dst, b, h) do { _Pragma("unroll") for (int n = 0; n < 2; ++n) _Pragma("unroll") for (int k = 0; k < 2; ++k) dst[n][k] = *(const PG8_LAS bf16x8*)(lds + PG8_SB(b, h) + boff + n * 2048 + k * 1024); } while (0)
#define PG8_MMA(ai, bj, At, Bt) do { __builtin_amdgcn_s_setprio(1); _Pragma("unroll") for (int m = 0; m < 4; ++m) _Pragma("unroll") for (int n = 0; n < 2; ++n) _Pragma("unroll") for (int k = 0; k < 2; ++k) \
        acc[ai][bj][m][n] = __builtin_amdgcn_mfma_f32_16x16x32_bf16(Bt[n][k], At[m][k], acc[ai][bj][m][n], 0, 0, 0); __builtin_amdgcn_s_setprio(0); } while (0)
#define PG8_WAIT_V(n) asm volatile("s_waitcnt vmcnt(" #n ")" ::: "memory")
#define PG8_WAIT_L(n) asm volatile("s_waitcnt lgkmcnt(" #n ")" ::: "memory")
#define PG8_BAR __builtin_amdgcn_s_barrier()
#define PG8_SCHED __builtin_amdgcn_sched_barrier(0)
    Unit cur, nxt; int ui = 0;
    if (!S.next(0, cur)) return;
    f32x4 acc[2][2][4][2];
#pragma unroll
    for (int a = 0; a < 2; ++a)
#pragma unroll
        for (int b = 0; b < 2; ++b)
#pragma unroll
            for (int m = 0; m < 4; ++m)
#pragma unroll
                for (int n = 0; n < 2; ++n) acc[a][b][m][n] = (f32x4){0.f, 0.f, 0.f, 0.f};
    bf16x8 At[4][2], B0[2][2], B1[2][2];
    const char* cA = (const char*)g.A + (size_t)cur.pm * tstepA; const char* cB = (const char*)g.Bt + (size_t)cur.pn * tstepB;
    S.a_ready(cur);
    if constexpr (SP2) {
        PG8_STAGE(PG8_SB(0, 0), cB, voffB); PG8_STAGE(PG8_SB(0, 1), cB + hstepB, voffB); PG8_STAGE(PG8_SA(0, 0), cA, voffA); PG8_STAGE(PG8_SA(0, 1), cA + hstepA, voffA);
        if (wr == 1) PG8_BAR;
        PG8_WAIT_V(2); PG8_BAR;
        PG8_STAGE(PG8_SB(1, 0), cB + kstep, voffB); PG8_STAGE(PG8_SA(1, 0), cA + kstep, voffA); PG8_STAGE(PG8_SB(1, 1), cB + hstepB + kstep, voffB);
        PG8_WAIT_V(6); PG8_BAR;
    } else {
        PG8_STAGE(PG8_SB(0, 0), cB, voffB); PG8_STAGE(PG8_SA(0, 0), cA, voffA); PG8_STAGE(PG8_SB(0, 1), cB + hstepB, voffB); PG8_STAGE(PG8_SA(0, 1), cA + hstepA, voffA);
        if (wr == 1) PG8_BAR;
        PG8_WAIT_V(4); PG8_BAR;
        PG8_STAGE(PG8_SB(1, 0), cB + kstep, voffB); PG8_STAGE(PG8_SA(1, 0), cA + kstep, voffA); PG8_STAGE(PG8_SB(1, 1), cB + hstepB + kstep, voffB);
        PG8_WAIT_V(6); PG8_BAR;
    }
    for (;;) {
        const bool has_next = S.next(ui + 1, nxt);
        const char* nA = has_next ? (const char*)g.A + (size_t)nxt.pm * tstepA : cA; const char* nB = has_next ? (const char*)g.Bt + (size_t)nxt.pn * tstepB : cB;
        for (int t = 0; t < nt; t += 2) {
            const bool last = (t == nt - 2);
            const char* a1 = cA + (size_t)(t + 1) * kstep;
            const char* a2 = last ? nA : cA + (size_t)(t + 2) * kstep; const char* b2 = last ? nB : cB + (size_t)(t + 2) * kstep;
            const char* a3 = a2 + kstep; const char* b3 = b2 + kstep;
            if (last && has_next) S.a_ready(nxt);
            if constexpr (SP2) {
            PG8_LDB(B0, 0, 0); PG8_LDB(B1, 0, 1); PG8_SCHED; PG8_LDA(At, 0, 0); PG8_STAGE(PG8_SA(1, 1), a1 + hstepA, voffA);
            PG8_WAIT_V(8); PG8_WAIT_L(0); PG8_BAR; PG8_MMA(0, 0, At, B0); PG8_MMA(0, 1, At, B1); PG8_BAR; PG8_SCHED;
            PG8_LDA(At, 0, 1); PG8_STAGE(PG8_SB(0, 0), b2, voffB); PG8_STAGE(PG8_SB(0, 1), b2 + hstepB, voffB); PG8_STAGE(PG8_SA(0, 0), a2, voffA);
            PG8_WAIT_V(8); PG8_WAIT_L(0); PG8_BAR; PG8_MMA(1, 0, At, B0); PG8_MMA(1, 1, At, B1); PG8_BAR; PG8_SCHED;
            PG8_LDB(B0, 1, 0); PG8_LDB(B1, 1, 1); PG8_SCHED; PG8_LDA(At, 1, 0); PG8_STAGE(PG8_SA(0, 1), a2 + hstepA, voffA);
            PG8_WAIT_V(8); PG8_WAIT_L(0); PG8_BAR; PG8_MMA(0, 0, At, B0); PG8_MMA(0, 1, At, B1); PG8_BAR; PG8_SCHED;
            PG8_LDA(At, 1, 1); PG8_STAGE(PG8_SB(1, 0), b3, voffB); PG8_STAGE(PG8_SB(1, 1), b3 + hstepB, voffB); PG8_STAGE(PG8_SA(1, 0), a3, voffA);
            PG8_WAIT_V(8); PG8_WAIT_L(0); PG8_BAR; PG8_MMA(1, 0, At, B0); PG8_MMA(1, 1, At, B1); PG8_BAR; PG8_SCHED;
            } else {
            PG8_LDB(B0, 0, 0); PG8_SCHED; PG8_LDA(At, 0, 0); PG8_STAGE(PG8_SA(1, 1), a1 + hstepA, voffA);
            PG8_WAIT_L(8); PG8_BAR; PG8_WAIT_L(0); PG8_MMA(0, 0, At, B0); PG8_BAR; PG8_SCHED;
            PG8_LDB(B1, 0, 1); PG8_STAGE(PG8_SB(0, 0), b2, voffB);
            PG8_BAR; PG8_WAIT_L(0); PG8_MMA(0, 1, At, B1); PG8_BAR;
            PG8_LDA(At, 0, 1); PG8_STAGE(PG8_SA(0, 0), a2, voffA);
            PG8_BAR; PG8_WAIT_L(0); PG8_MMA(1, 0, At, B0); PG8_BAR; PG8_SCHED;
            PG8_STAGE(PG8_SB(0, 1), b2 + hstepB, voffB);
            PG8_WAIT_V(6); PG8_BAR; PG8_MMA(1, 1, At, B1); PG8_BAR;
            PG8_LDB(B0, 1, 0); PG8_SCHED; PG8_LDA(At, 1, 0); PG8_STAGE(PG8_SA(0, 1), a2 + hstepA, voffA);
            PG8_WAIT_L(8); PG8_BAR; PG8_WAIT_L(0); PG8_MMA(0, 0, At, B0); PG8_BAR; PG8_SCHED;
            PG8_LDB(B1, 1, 1); PG8_STAGE(PG8_SB(1, 0), b3, voffB);
            PG8_BAR; PG8_WAIT_L(0); PG8_MMA(0, 1, At, B1); PG8_BAR;
            PG8_LDA(At, 1, 1); PG8_STAGE(PG8_SA(1, 0), a3, voffA);
            PG8_BAR; PG8_WAIT_L(0); PG8_MMA(1, 0, At, B0); PG8_BAR; PG8_SCHED;
            PG8_STAGE(PG8_SB(1, 1), b3 + hstepB, voffB);
            PG8_WAIT_V(6); PG8_BAR; PG8_MMA(1, 1, At, B1); PG8_BAR;
            }
        }
        if constexpr (ALIGN_EPI) { if (wr == 0) PG8_BAR; }
        if constexpr (!Epi::AFTER_DRAIN) { const int el = lane_id_here(); E(acc, cur, wr, wc, el & 15, el >> 4); S.done(cur); }
        if (!has_next) break;
#pragma unroll
        for (int a = 0; a < 2; ++a)
#pragma unroll
            for (int b = 0; b < 2; ++b)
#pragma unroll
                for (int m = 0; m < 4; ++m)
#pragma unroll
                    for (int n = 0; n < 2; ++n) acc[a][b][m][n] = (f32x4){0.f, 0.f, 0.f, 0.f};
        cur = nxt; cA = nA; cB = nB; ++ui;
        if constexpr (ALIGN_EPI) { if (wr == 1) PG8_BAR; }
    }
    PG8_WAIT_V(0);
    if constexpr (!ALIGN_EPI) { if (wr == 0) PG8_BAR; }
    PG8_BAR;
    if constexpr (Epi::AFTER_DRAIN) { E.fused(acc, cur, wr, wc, fr, fq, lds, wid, lane); S.done(cur); }
#undef PG8_SA
#undef PG8_SB
#undef PG8_STAGE
#undef PG8_LDA
#undef PG8_LDB
#undef PG8_MMA
#undef PG8_WAIT_V
#undef PG8_WAIT_L
#undef PG8_BAR
#undef PG8_SCHED
}
}
namespace {
using pg8::f32x4; using pg8::u32x4; using pg8::Unit;
__device__ __forceinline__ float fast_sigmoid(float x) { return __builtin_amdgcn_rcpf(1.f + __expf(-x)); }
__device__ __forceinline__ f32x4 bf4_lo(unsigned a, unsigned b) { return (f32x4){__uint_as_float(a << 16), __uint_as_float(a & 0xffff0000u), __uint_as_float(b << 16), __uint_as_float(b & 0xffff0000u)}; }
__device__ __forceinline__ u32x4 pack8(const f32x4& v0, const f32x4& v1) { u32x4 w; w.x = pg8::cvt_pk_bf16(v0[0], v0[1]); w.y = pg8::cvt_pk_bf16(v0[2], v0[3]); w.z = pg8::cvt_pk_bf16(v1[0], v1[1]); w.w = pg8::cvt_pk_bf16(v1[2], v1[3]); return w; }
typedef GAS const unsigned long long* gcu64; typedef GAS unsigned long long* gu64;
__device__ __forceinline__ float rstd_of(gcu64 ssq, int row) { return rsqrtf((float)ssq[row] * (1.f / (1048576.f * D)) + 1e-6f); }
struct EpiInproj {
    static constexpr bool PERM = true, AFTER_DRAIN = false;
    gb16 P; gcf32 bias; gcu64 ssq;
    __device__ __forceinline__ void operator()(const f32x4 (&acc)[2][2][4][2], const Unit& u, int wr, int wc, int fr, int fq) const {
        const int row0 = u.pm * 256 + wr * 64 + fr, col0 = u.pn * 256 + wc * 32 + 8 * fq; gcf32 bb = bias + (size_t)(u.pm >> 3) * PC + col0;
        f32x4 bv[2][2];
#pragma unroll
        for (int bj = 0; bj < 2; ++bj)
#pragma unroll
            for (int n = 0; n < 2; ++n) bv[bj][n] = *(const GAS f32x4*)(bb + bj * 128 + 4 * n);
        float rsv[2][4];
#pragma unroll
        for (int ai = 0; ai < 2; ++ai)
#pragma unroll
            for (int m = 0; m < 4; ++m) rsv[ai][m] = rstd_of(ssq, row0 + ai * 128 + m * 16);
#pragma unroll
        for (int ai = 0; ai < 2; ++ai)
#pragma unroll
            for (int m = 0; m < 4; ++m) { const int row = row0 + ai * 128 + m * 16; gb16 rowp = P + (size_t)row * PC + col0; const float rs = rsv[ai][m];
#pragma unroll
                for (int bj = 0; bj < 2; ++bj) { const f32x4 v0 = acc[ai][bj][m][0] * rs + bv[bj][0], v1 = acc[ai][bj][m][1] * rs + bv[bj][1];
                    *(GAS u32x4*)(rowp + bj * 128) = pack8(v0, v1); } }
    }
};
struct EpiFfnIn {
    static constexpr bool PERM = true, AFTER_DRAIN = false;
    gb16 ACT; gcf32 bias; gcu64 ssq;
    __device__ __forceinline__ void operator()(const f32x4 (&acc)[2][2][4][2], const Unit& u, int wr, int wc, int fr, int fq) const {
        const int row0 = u.pm * 256 + wr * 64 + fr, col0 = u.pn * 128 + wc * 32 + 8 * fq; gcf32 bb = bias + (size_t)(u.pm >> 3) * 2 * DFF + u.pn * 256 + wc * 32 + 8 * fq;
        f32x4 bv[2][2];
#pragma unroll
        for (int bj = 0; bj < 2; ++bj)
#pragma unroll
            for (int n = 0; n < 2; ++n) bv[bj][n] = *(const GAS f32x4*)(bb + bj * 128 + 4 * n);
        float rsv[2][4];
#pragma unroll
        for (int ai = 0; ai < 2; ++ai)
#pragma unroll
            for (int m = 0; m < 4; ++m) rsv[ai][m] = rstd_of(ssq, row0 + ai * 128 + m * 16);
#pragma unroll
        for (int ai = 0; ai < 2; ++ai)
#pragma unroll
            for (int m = 0; m < 4; ++m) { const int row = row0 + ai * 128 + m * 16; const float rs = rsv[ai][m]; f32x4 o[2];
#pragma unroll
                for (int n = 0; n < 2; ++n) { const f32x4 g = acc[ai][0][m][n] * rs + bv[0][n], up = acc[ai][1][m][n] * rs + bv[1][n];
#pragma unroll
                    for (int e = 0; e < 4; ++e) o[n][e] = g[e] * fast_sigmoid(g[e]) * up[e]; }
                *(GAS u32x4*)(ACT + (size_t)row * DFF + col0) = pack8(o[0], o[1]); }
    }
};
constexpr int RES_CH = 2;
template <int e16> __device__ __forceinline__ float swz16(float v) { return __int_as_float(__builtin_amdgcn_ds_swizzle(__float_as_int(v), (e16 << 10) | 0x1F)); }
struct EpiRes {
    static constexpr bool PERM = true, AFTER_DRAIN = false;
    gcf32 Xin32; gcb16 Xin16; gf32 Xout32; gb16 Xout16;
    gcf32 g;
    gu64 ssq_out; gb16 Hn; gcf32 gain_n; gcf32 sc_n;
    __device__ __forceinline__ void operator()(const f32x4 (&acc)[2][2][4][2], const Unit& u, int wr, int wc, int fr, int fq) const {
        const int row0 = u.pm * 256 + wr * 64 + fr, col0 = u.pn * 256 + wc * 32 + 8 * fq; const size_t boff = (size_t)(u.pm >> 3) * 6 * D + col0;
        f32x4 gv[2][2], gm[2][2];
#pragma unroll
        for (int bj = 0; bj < 2; ++bj)
#pragma unroll
            for (int n = 0; n < 2; ++n) { gv[bj][n] = *(const GAS f32x4*)(g + boff + bj * 128 + 4 * n);
                if (Hn) { const f32x4 ga = *(const GAS f32x4*)(gain_n + col0 + bj * 128 + 4 * n), sc = *(const GAS f32x4*)(sc_n + boff + bj * 128 + 4 * n); gm[bj][n] = ga * (sc + 1.0f); } }
#pragma unroll
        for (int am = 0; am < 8; am += RES_CH) {
            f32x4 xi[RES_CH][2][2];
            if (Xin16) {
                u32x4 xw[RES_CH][2];
#pragma unroll
                for (int mm = 0; mm < RES_CH; ++mm)
#pragma unroll
                    for (int bj = 0; bj < 2; ++bj) xw[mm][bj] = *(const GAS u32x4*)(Xin16 + (size_t)(row0 + ((am + mm) >> 2) * 128 + ((am + mm) & 3) * 16) * D + col0 + bj * 128);
#pragma unroll
                for (int mm = 0; mm < RES_CH; ++mm)
#pragma unroll
                    for (int bj = 0; bj < 2; ++bj) { xi[mm][bj][0] = bf4_lo(xw[mm][bj].x, xw[mm][bj].y); xi[mm][bj][1] = bf4_lo(xw[mm][bj].z, xw[mm][bj].w); }
            } else {
#pragma unroll
                for (int mm = 0; mm < RES_CH; ++mm)
#pragma unroll
                    for (int bj = 0; bj < 2; ++bj)
#pragma unroll
                        for (int n = 0; n < 2; ++n) xi[mm][bj][n] = *(const GAS f32x4*)(Xin32 + (size_t)(row0 + ((am + mm) >> 2) * 128 + ((am + mm) & 3) * 16) * D + col0 + bj * 128 + 4 * n);
            }
#pragma unroll
            for (int mm = 0; mm < RES_CH; ++mm) { const int ai = (am + mm) >> 2, m = (am + mm) & 3, row = row0 + ai * 128 + m * 16; const size_t off = (size_t)row * D + col0; float s = 0.f;
#pragma unroll
                for (int bj = 0; bj < 2; ++bj) { f32x4 xn[2];
#pragma unroll
                    for (int n = 0; n < 2; ++n) { xn[n] = xi[mm][bj][n] + gv[bj][n] * acc[ai][bj][m][n];
                        s += (xn[n][0] * xn[n][0] + xn[n][1] * xn[n][1]) + (xn[n][2] * xn[n][2] + xn[n][3] * xn[n][3]); }
                    if (Xout16) *(GAS u32x4*)(Xout16 + off + bj * 128) = pack8(xn[0], xn[1]);
                    else { *(GAS f32x4*)(Xout32 + off + bj * 128) = xn[0]; *(GAS f32x4*)(Xout32 + off + bj * 128 + 4) = xn[1]; }
                    if (Hn) *(GAS u32x4*)(Hn + off + bj * 128) = pack8(xn[0] * gm[bj][0], xn[1] * gm[bj][1]); }
                s += swz16<16>(s); { auto rr = __builtin_amdgcn_permlane32_swap(__float_as_uint(s), __float_as_uint(s), false, false); s = __uint_as_float(rr[0]) + __uint_as_float(rr[1]); }
                if (fq == 0) atomicAdd((unsigned long long*)(ssq_out + row), (unsigned long long)(s * 1048576.f + 0.5f)); } }
    }
};
struct EpiMod {
    static constexpr bool PERM = false, AFTER_DRAIN = false;
    gf32 mod; gcf32 b_mod; gb16 sh1, sh2;
    __device__ __forceinline__ void operator()(const f32x4 (&acc)[2][2][4][2], const Unit& u, int wr, int wc, int fr, int fq) const {
        if (wr != 0) return;
        const int col0 = u.pn * 256 + wc * 32 + 4 * fq;
#pragma unroll
        for (int bj = 0; bj < 2; ++bj)
#pragma unroll
            for (int n = 0; n < 2; ++n) { const int c = col0 + bj * 128 + n * 16; const f32x4 v = acc[0][bj][0][n] + *(const GAS f32x4*)(b_mod + c);
                *(GAS f32x4*)(mod + (size_t)fr * 6 * D + c) = v;
                gb16 sh = c < D ? sh1 + c : (c >= 3 * D && c < 4 * D) ? sh2 + (c - 3 * D) : (gb16)nullptr;
                if (sh) { u32x2v w; w.x = pg8::cvt_pk_bf16(v[0], v[1]); w.y = pg8::cvt_pk_bf16(v[2], v[3]); *(GAS u32x2v*)(sh + (size_t)fr * D) = w; } }
    }
};
struct EpiBias {
    static constexpr bool PERM = false, AFTER_DRAIN = false;
    gf32 out; int ncols; gcf32 add; int add_from;
    __device__ __forceinline__ void operator()(const f32x4 (&acc)[2][2][4][2], const Unit& u, int wr, int wc, int fr, int fq) const {
        if (wr != 0) return;
        const int col0 = u.pn * 256 + wc * 32 + 4 * fq;
#pragma unroll
        for (int bj = 0; bj < 2; ++bj)
#pragma unroll
            for (int n = 0; n < 2; ++n) { const int c = col0 + bj * 128 + n * 16; f32x4 v = acc[0][bj][0][n];
                if (add && c >= add_from) v = v + *(const GAS f32x4*)(add + (c - add_from));
                *(GAS f32x4*)(out + (size_t)fr * ncols + c) = v; }
    }
};
struct EpiGlu {
    static constexpr bool PERM = true, AFTER_DRAIN = false;
    gb16 P;
    __device__ __forceinline__ void operator()(const f32x4 (&acc)[2][2][4][2], const Unit& u, int wr, int wc, int fr, int fq) const {
        const int row0 = u.pm * 256 + wr * 64 + fr, col0 = u.pn * 128 + wc * 32 + 8 * fq;
#pragma unroll
        for (int ai = 0; ai < 2; ++ai) {
            u32x4 gwv[4];
#pragma unroll
            for (int m = 0; m < 4; ++m) gwv[m] = *(const GAS u32x4*)(P + (size_t)(row0 + ai * 128 + m * 16) * PC + PC_G + D + col0);
#pragma unroll
            for (int m = 0; m < 4; ++m) { gb16 rowp = P + (size_t)(row0 + ai * 128 + m * 16) * PC;
                const u32x4 gw = gwv[m]; f32x4 g0 = bf4_lo(gw.x, gw.y), g1 = bf4_lo(gw.z, gw.w); f32x4 o[2];
#pragma unroll
                for (int e = 0; e < 4; ++e) { g0[e] = fast_sigmoid(g0[e]); g1[e] = fast_sigmoid(g1[e]); }
#pragma unroll
                for (int e = 0; e < 4; ++e) { o[0][e] = g0[e] * acc[ai][0][m][0][e] * fast_sigmoid(acc[ai][1][m][0][e]); o[1][e] = g1[e] * acc[ai][0][m][1][e] * fast_sigmoid(acc[ai][1][m][1][e]); }
                *(GAS u32x4*)(rowp + col0) = pack8(o[0], o[1]); } }
    }
};
struct EpiMixAcc {
    static constexpr bool PERM = true, AFTER_DRAIN = false;
    gb16 P; int gate_off;
    __device__ __forceinline__ void operator()(const f32x4 (&acc)[2][2][4][2], const Unit& u, int wr, int wc, int fr, int fq) const {
        const int row0 = u.pm * 256 + wr * 64 + fr, col0 = u.pn * 256 + wc * 32 + 8 * fq;
#pragma unroll
        for (int am = 0; am < 8; ++am) { const int ai = am >> 2, m0 = am & 3;
            u32x4 gwv[1][2], owv[1][2];
#pragma unroll
            for (int mm = 0; mm < 1; ++mm)
#pragma unroll
                for (int bj = 0; bj < 2; ++bj) { gcb16 rp = P + (size_t)(row0 + ai * 128 + (m0 + mm) * 16) * PC + col0 + bj * 128; gwv[mm][bj] = *(const GAS u32x4*)(rp + gate_off); owv[mm][bj] = *(const GAS u32x4*)rp; }
#pragma unroll
            for (int mm = 0; mm < 1; ++mm) { const int m = m0 + mm; gb16 rowp = P + (size_t)(row0 + ai * 128 + m * 16) * PC;
#pragma unroll
                for (int bj = 0; bj < 2; ++bj) { const int c = col0 + bj * 128;
                    const u32x4 gw = gwv[mm][bj], ow = owv[mm][bj];
                    f32x4 g0 = bf4_lo(gw.x, gw.y), g1 = bf4_lo(gw.z, gw.w);
#pragma unroll
                    for (int e = 0; e < 4; ++e) { g0[e] = fast_sigmoid(g0[e]); g1[e] = fast_sigmoid(g1[e]); }
                    const f32x4 v0 = bf4_lo(ow.x, ow.y) + g0 * acc[ai][bj][m][0], v1 = bf4_lo(ow.z, ow.w) + g1 * acc[ai][bj][m][1];
                    *(GAS u32x4*)(rowp + c) = pack8(v0, v1); } } }
    }
};

#define XB_TMO      128
#define XB_XCNT(j)  (256  + 64 * (j))
#define XB_XSUB(j)  (1280 + 64 * (j))
#define XB_XGEN(j)  (2304 + 64 * (j))
#define XB_TOP      3328
#define XB_TOPGEN   3392
#define XCD_BAR_WORDS 3456
#define XB_SPIN_CAP (1u << 20)
__device__ __forceinline__ unsigned xb_ld(unsigned* p)              { return __hip_atomic_load(p, __ATOMIC_RELAXED, __HIP_MEMORY_SCOPE_AGENT); }
__device__ __forceinline__ unsigned xb_add(unsigned* p, unsigned v) { return __hip_atomic_fetch_add(p, v, __ATOMIC_RELAXED, __HIP_MEMORY_SCOPE_AGENT); }
__device__ __forceinline__ unsigned xb_xcc_id() { return (unsigned)__builtin_amdgcn_s_getreg((3 << 11) | 20) & 0xFu; }
#define XB_SPIN(cond, bar) do { unsigned _sp = 0; while (cond) { __builtin_amdgcn_s_sleep(1); \
    if ((++_sp & 255u) == 0u) { if (xb_ld(&(bar)[XB_TMO])) break; if (_sp > XB_SPIN_CAP) { atomicAdd(&(bar)[XB_TMO], 1u); break; } } } } while (0)
struct XcdBarrier { unsigned* bar; unsigned x; volatile LAS unsigned* st; };
__device__ __forceinline__ XcdBarrier xcd_barrier_post(unsigned* bar, volatile LAS unsigned* st, int wave_s) {
    XcdBarrier b; b.bar = bar; b.x = xb_xcc_id(); b.st = st;
    if (wave_s == 0 && lane_id_here() == 0) (void)xb_add(&bar[XB_XCNT(b.x)], 1u);
    return b;
}
__device__ __forceinline__ void xcd_barrier_complete(unsigned* bar, unsigned x, unsigned& nloc, unsigned& nx) {
    const unsigned G = gridDim.x * gridDim.y * gridDim.z;
    unsigned sum, cnt, mine, sp = 0u;
    for (;;) {
        sum = 0u; cnt = 0u; mine = 0u;
#pragma unroll
        for (unsigned j = 0; j < 16; ++j) { const unsigned c = xb_ld(&bar[XB_XCNT(j)]); sum += c; cnt += (c > 0u) ? 1u : 0u; mine = (j == x) ? c : mine; }
        if (sum == G) break;
        __builtin_amdgcn_s_sleep(1);
        if ((++sp & 255u) == 0u) { if (xb_ld(&bar[XB_TMO])) break; if (sp > XB_SPIN_CAP) { atomicAdd(&bar[XB_TMO], 1u); break; } }
    }
    nloc = mine > 0u ? mine : 1u; nx = cnt > 0u ? cnt : 1u;
}
__device__ __forceinline__ void xcd_barrier(const XcdBarrier& b, int wave_s) {
    asm volatile("s_waitcnt vmcnt(0)" ::: "memory");
    __syncthreads();
    if (wave_s == 0 && lane_id_here() == 0) {
        unsigned* bar = b.bar; unsigned bx = b.x; asm volatile("" : "+s"(bar), "+s"(bx));
        __builtin_amdgcn_s_waitcnt(0);
        unsigned nloc = b.st[0], nx = b.st[1];
        if (nloc == 0u) { xcd_barrier_complete(bar, bx, nloc, nx); b.st[0] = nloc; b.st[1] = nx; }
        const unsigned old = xb_add(&bar[XB_XSUB(bx)], 1u);
        const unsigned gen = old / nloc;
        if (old + 1u == (gen + 1u) * nloc) {
            __builtin_amdgcn_fence(__ATOMIC_RELEASE, "agent");
            asm volatile("s_waitcnt vmcnt(0)" ::: "memory");
            const unsigned og = xb_add(&bar[XB_TOP], 1u);
            const unsigned tg = og / nx;
            if (og + 1u == (tg + 1u) * nx) xb_add(&bar[XB_TOPGEN], 1u);
            else XB_SPIN(xb_ld(&bar[XB_TOPGEN]) == tg, bar);
            __builtin_amdgcn_fence(__ATOMIC_ACQUIRE, "agent");
            xb_add(&bar[XB_XGEN(bx)], 1u);
            asm volatile("s_waitcnt vmcnt(0)" ::: "memory");
        } else {
            XB_SPIN(xb_ld(&bar[XB_XGEN(bx)]) == gen, bar);
            __builtin_amdgcn_fence(__ATOMIC_ACQUIRE, "agent");
            asm volatile("s_waitcnt vmcnt(0)" ::: "memory");
        }
    }
    __syncthreads();
}


struct Args { const float* in[24]; float* out; unsigned char* ws; };

template <int K> __device__ __forceinline__ float swz_xor(float v) { return __int_as_float(__builtin_amdgcn_ds_swizzle(__float_as_int(v), (K << 10) | 0x1F)); }
__device__ __forceinline__ float wave_sum(float v) { v += swz_xor<1>(v); v += swz_xor<2>(v); v += swz_xor<4>(v); v += swz_xor<8>(v); v += swz_xor<16>(v);
    auto rr = __builtin_amdgcn_permlane32_swap(__float_as_uint(v), __float_as_uint(v), false, false); return __uint_as_float(rr[0]) + __uint_as_float(rr[1]); }
__device__ __forceinline__ unsigned sortable(float f) { const unsigned b = __float_as_uint(f); return (b & 0x80000000u) ? ~b : (b | 0x80000000u); }
__device__ __forceinline__ float unsortable(unsigned u) { return __uint_as_float((u & 0x80000000u) ? (u ^ 0x80000000u) : ~u); }

__device__ __forceinline__ void ph_a16(gcf32 c, gb16 A16, gu64 ssq, int gw, int lane) {
    for (int it = gw * 64 + lane; it < 4 * M; it += NGW * 64) ssq[M + it] = 0ull;
    for (int it = gw * 64 + lane; it < 5 * 256 * D / 8; it += NGW * 64) { const int e = it * 8, mtx = e / (256 * D), r = (e / D) & 255, k = e & (D - 1);
        u32x4 w = {0u, 0u, 0u, 0u};
        if (mtx == 0 && r < 16) { gcf32 cp = c + r * D + k; w.x = pg8::cvt_pk_bf16(siluf_(cp[0]), siluf_(cp[1])); w.y = pg8::cvt_pk_bf16(siluf_(cp[2]), siluf_(cp[3])); w.z = pg8::cvt_pk_bf16(siluf_(cp[4]), siluf_(cp[5])); w.w = pg8::cvt_pk_bf16(siluf_(cp[6]), siluf_(cp[7])); }
        if (mtx == 0 || r >= 16) *(GAS u32x4*)(A16 + e) = w; }
}
__device__ __forceinline__ void ph_h0(gcf32 x, gcf32 gain, gcf32 modl, int sc_off, gb16 H, gu64 ssq, int gw, int ngw, int lane) {
    for (int t0 = 4 * gw; t0 < M; t0 += 4 * ngw) {
        const int b = t0 / S; f32x4v v[4][4]; float s[4];
#pragma unroll
        for (int q = 0; q < 4; ++q) { const GAS f32x4v* xr = (const GAS f32x4v*)(x + (size_t)(t0 + q) * D) + lane;
#pragma unroll
            for (int j = 0; j < 4; ++j) v[q][j] = xr[64 * j]; }
        gcf32 mb = modl + (size_t)b * 6 * D; f32x4v gm[4];
#pragma unroll
        for (int j = 0; j < 4; ++j) { const int k = 4 * lane + 256 * j; const f32x4v g = *(const GAS f32x4v*)(gain + k), sc = *(const GAS f32x4v*)(mb + sc_off + k); gm[j] = g * (sc + 1.0f); }
#pragma unroll
        for (int q = 0; q < 4; ++q) { float a = 0.f;
#pragma unroll
            for (int j = 0; j < 4; ++j) a += v[q][j].x * v[q][j].x + v[q][j].y * v[q][j].y + v[q][j].z * v[q][j].z + v[q][j].w * v[q][j].w;
            s[q] = wave_sum(a); }
        if (lane < 4) ssq[t0 + lane] = (unsigned long long)((lane == 0 ? s[0] : lane == 1 ? s[1] : lane == 2 ? s[2] : s[3]) * 1048576.f + 0.5f);
#pragma unroll
        for (int q = 0; q < 4; ++q)
#pragma unroll
            for (int j = 0; j < 4; ++j) { const int k = 4 * lane + 256 * j; const f32x4v o = v[q][j] * gm[j];
                u32x2v w; w.x = pg8::cvt_pk_bf16(o.x, o.y); w.y = pg8::cvt_pk_bf16(o.z, o.w); *(GAS u32x2v*)(H + (size_t)(t0 + q) * D + k) = w; }
    }
}
__device__ __forceinline__ void ph_final_norm(gcf32 x, gf32 out, gcf32 gain, gcu64 ssq, int gw, int lane) {
    f32x4v g[4];
#pragma unroll
    for (int j = 0; j < 4; ++j) g[j] = *(const GAS f32x4v*)(gain + 4 * lane + 256 * j);
    for (int t0 = 4 * gw; t0 < M; t0 += 4 * NGW) {
        f32x4v v[4][4]; float rs[4];
#pragma unroll
        for (int q = 0; q < 4; ++q) { const GAS f32x4v* xr = (const GAS f32x4v*)(x + (size_t)(t0 + q) * D) + lane; rs[q] = rstd_of(ssq, t0 + q);
#pragma unroll
            for (int j = 0; j < 4; ++j) v[q][j] = xr[64 * j]; }
#pragma unroll
        for (int q = 0; q < 4; ++q) { GAS f32x4v* xr = (GAS f32x4v*)(out + (size_t)(t0 + q) * D) + lane;
#pragma unroll
            for (int j = 0; j < 4; ++j) xr[64 * j] = v[q][j] * g[j] * rs[q]; }
    }
}
__device__ __forceinline__ f32x4 ld_bf4(gcb16 p) { const u32x2v w = *(const GAS u32x2v*)p; return bf4_lo(w.x, w.y); }
__device__ __forceinline__ void ph_conv(gcb16 P, gcf32 conv_w, gb16 CONVA, int gw, int lane) {
    const int j0 = 4 * lane;
    const f32x4 w0 = *(const GAS f32x4*)(conv_w + j0), w1 = *(const GAS f32x4*)(conv_w + 256 + j0), w2 = *(const GAS f32x4*)(conv_w + 512 + j0);
    for (int run = gw; run < M / 16; run += NGW) {
        const int t0 = 16 * run; f32x4 z1 = {0.f, 0.f, 0.f, 0.f}, z2 = {0.f, 0.f, 0.f, 0.f};
        if ((t0 & (S - 1)) != 0) { gcb16 p1 = P + (size_t)(t0 - 1) * PC + j0, p2 = P + (size_t)(t0 - 2) * PC + j0; z1 = ld_bf4(p1 + 256) * ld_bf4(p1 + 512); z2 = ld_bf4(p2 + 256) * ld_bf4(p2 + 512); }
#pragma unroll 4
        for (int i = 0; i < 16; ++i) { gcb16 p = P + (size_t)(t0 + i) * PC + j0;
            const f32x4 z0 = ld_bf4(p + 256) * ld_bf4(p + 512), y = ld_bf4(p) * (w0 * z2 + w1 * z1 + w2 * z0);
            u32x2v o; o.x = pg8::cvt_pk_bf16(y[0], y[1]); o.y = pg8::cvt_pk_bf16(y[2], y[3]); *(GAS u32x2v*)(CONVA + (size_t)(t0 + i) * 256 + j0) = o;
            z2 = z1; z1 = z0; }
    }
}

typedef short bf16x8_t __attribute__((ext_vector_type(8)));
typedef float f32x16_t __attribute__((ext_vector_type(16)));
#define MFMA32(a, b, c) __builtin_amdgcn_mfma_f32_32x32x16_bf16((a), (b), (c), 0, 0, 0)
__device__ __forceinline__ int crow16(int r, int h) { return (r & 3) + 8 * (r >> 2) + 4 * h; }
__device__ __forceinline__ void ph_ssm_params(gcf32 a_re, gcf32 a_im, gcf32 log_dt, gcf32 b_re, gcf32 b_im, gf32 SSMP, gf32 AP, int gw, int lane) {
    for (int it = gw * 64 + lane; it < NL * 1024; it += NGW * 64) {
        const int l = it >> 10, gp = it & 1023, g = gp >> 6;
        const double dt = exp((double)log_dt[l * 16 + g]), ar = a_re[l * 1024 + gp], ai = a_im[l * 1024 + gp];
        const double mag = exp(dt * ar), abr = mag * cos(dt * ai), abi = mag * sin(dt * ai);
        const double den = ar * ar + ai * ai, nr = abr - 1.0, ni = abi;
        const double cr = (nr * ar + ni * ai) / den, ci = (ni * ar - nr * ai) / den;
        gf32 o = SSMP + (size_t)l * SSMP_LAYER;
        o[gp * 2] = (float)abr; o[gp * 2 + 1] = (float)abi;
        for (int j = 0; j < 16; ++j) { const double br = b_re[(l * 1024 + gp) * 16 + j], bi = b_im[(l * 1024 + gp) * 16 + j];
            o[2048 + (gp * 16 + j) * 2] = (float)(cr * br - ci * bi); o[2048 + (gp * 16 + j) * 2 + 1] = (float)(cr * bi + ci * br); }
    }
    for (int it = gw * 64 + lane; it < NL * 1024 * 65; it += NGW * 64) {
        const int d = it % 65, lgp = it / 65, l = lgp >> 10, gp = lgp & 1023, g = gp >> 6;
        const double dt = exp((double)log_dt[l * 16 + g]), ar = a_re[l * 1024 + gp], ai = a_im[l * 1024 + gp];
        const double m2 = exp((double)d * dt * ar), ang = (double)d * dt * ai;
        AP[(size_t)it * 2] = (float)(m2 * cos(ang)); AP[(size_t)it * 2 + 1] = (float)(m2 * sin(ang));
    }
}
__device__ __forceinline__ void ph_ssm_kd(gcf32 a_re, gcf32 a_im, gcf32 log_dt, gcf32 b_re, gcf32 b_im, gcf32 c_re, gcf32 c_im, gf32 KD, LAS float* scr, int gw, int lane) {
    for (int it = gw; it < NL * 16 * 64; it += NGW) {
        const int d = it & 63, lg = it >> 6;
        { const int gp = lg * 64 + lane; const double dt = exp((double)log_dt[lg]), ar = a_re[gp], ai = a_im[gp];
          const double mag = exp(dt * ar), abr = mag * cos(dt * ai), abi = mag * sin(dt * ai), den = ar * ar + ai * ai, nr = abr - 1.0, ni = abi;
          const double cr = (nr * ar + ni * ai) / den, ci = (ni * ar - nr * ai) / den, md = exp((double)d * dt * ar), ang = (double)d * dt * ai, pr = md * cos(ang), pi = md * sin(ang);
          asm volatile("s_waitcnt lgkmcnt(0)" ::: "memory");
          scr[2 * lane] = (float)(pr * cr - pi * ci); scr[2 * lane + 1] = (float)(pr * ci + pi * cr); }
        asm volatile("s_waitcnt lgkmcnt(0)" ::: "memory");
        const int jp = lane & 15, jq = lane >> 4; float acc[4] = {0.f, 0.f, 0.f, 0.f};
        gcf32 br = b_re + (size_t)lg * 1024 + jp, bi = b_im + (size_t)lg * 1024 + jp, cr_ = c_re + (size_t)lg * 1024 + jq * 64, ci_ = c_im + (size_t)lg * 1024 + jq * 64;
#pragma unroll 4
        for (int p = 0; p < 64; ++p) { const float er = scr[2 * p], ei = scr[2 * p + 1], b0 = br[p * 16], b1 = bi[p * 16]; const float zr = er * b0 - ei * b1, zi = er * b1 + ei * b0;
#pragma unroll
            for (int i = 0; i < 4; ++i) acc[i] += cr_[i * 256 + p] * zr - ci_[i * 256 + p] * zi; }
#pragma unroll
        for (int i = 0; i < 4; ++i) KD[((size_t)lg * 64 + d) * 256 + (jq + 4 * i) * 16 + jp] = acc[i];
    }
}
__device__ __forceinline__ void ph_ssm_frags(gcf32 c_re, gcf32 c_im, gcf32 SSMP, gcf32 AP, gcf32 KD, gu8 T, int gw, int lane) {
    const int n = lane & 31, h = lane >> 5;
    for (int f = gw; f < NL * 16 * SSM_NFRAG; f += NGW) {
        const int l = f / (16 * SSM_NFRAG), g = (f / SSM_NFRAG) & 15, k = f % SSM_NFRAG;
        gcf32 ap = AP + (size_t)((l * 16 + g) * 64) * 65 * 2;
        gcf32 bb = SSMP + (size_t)l * SSMP_LAYER + 2048 + (size_t)(g * 64) * 32;
        gcf32 cr = c_re + (size_t)((l * 16 + g) * 16) * 64; gcf32 ci = c_im + (size_t)((l * 16 + g) * 16) * 64;
        float v[8];
        if (k < 65) {
            const int tt = n >> 4, j = n & 15, d = k - 1 + tt;
            if (d >= 0) { gcf32 kd = KD + ((size_t)((l * 16 + g) * 64 + d)) * 256 + j * 16 + 8 * h; const f32x4 k0 = *(const GAS f32x4*)kd, k1 = *(const GAS f32x4*)(kd + 4);
                v[0] = k0[0]; v[1] = k0[1]; v[2] = k0[2]; v[3] = k0[3]; v[4] = k1[0]; v[5] = k1[1]; v[6] = k1[2]; v[7] = k1[3]; }
            else {
#pragma unroll
                for (int e = 0; e < 8; ++e) v[e] = 0.f; }
        } else if (k < 65 + 256) {
            const int kk = k - 65, nb = kk >> 6, s = kk & 63, ng = 32 * nb + n, ri = ng >> 6, p = ng & 63;
            const float adr = ap[(p * 65 + 63 - s) * 2], adi = ap[(p * 65 + 63 - s) * 2 + 1];
#pragma unroll
            for (int e = 0; e < 8; ++e) { const float br = bb[(p * 16 + 8 * h + e) * 2], bi = bb[(p * 16 + 8 * h + e) * 2 + 1]; v[e] = ri == 0 ? adr * br - adi * bi : adr * bi + adi * br; }
        } else {
            const int kk = k - 321, nb = kk >> 3, ks = kk & 7, t = 2 * nb + (n >> 4), j = n & 15;
#pragma unroll
            for (int e = 0; e < 8; ++e) { const int kg = 16 * ks + 8 * h + e, ri = kg >> 6, p = kg & 63;
                const float adr = ap[(p * 65 + t + 1) * 2], adi = ap[(p * 65 + t + 1) * 2 + 1], cjr = cr[j * 64 + p], cji = ci[j * 64 + p];
                v[e] = ri == 0 ? cjr * adr - cji * adi : -(cjr * adi + cji * adr); }
        }
        u32x4 o; o.x = pg8::cvt_pk_bf16(v[0], v[1]); o.y = pg8::cvt_pk_bf16(v[2], v[3]); o.z = pg8::cvt_pk_bf16(v[4], v[5]); o.w = pg8::cvt_pk_bf16(v[6], v[7]);
        *(GAS u32x4*)(T + (size_t)l * SSMT_LAYER + ((size_t)(g * SSM_NFRAG + k) * 64 + lane) * 16) = o;
    }
}
constexpr int SSM_UROW = 2064, SSM_HROW = 272, SSM_SL_OFF = 32 * SSM_UROW, SSM_HP_OFF = SSM_SL_OFF + 16384, SSM_LDS = SSM_HP_OFF + 32 * SSM_HROW;
__device__ __forceinline__ void ssm_fast_item(LAS unsigned char* lds, gcb16 P, gcu8 T  , gcf32 AP  , gcf32 d_skip, gb16 Z, int b, int g, int wave_s) {
    const int lane = lane_id_here(), tid = wave_s * 64 + lane, n = lane & 31, h = lane >> 5;
    gcu8 Tg = T + (size_t)g * SSM_NFRAG * 1024;
#pragma unroll
    for (int i = 0; i < 4; ++i) { const int tok = tid + 512 * i; const GAS u32x4* src = (const GAS u32x4*)(P + (size_t)(b * S + tok) * PC + PC_SSM + g * 16);
        const u32x4 v0 = src[0], v1 = src[1]; LAS u32x4* dst = (LAS u32x4*)(lds + (tok >> 6) * SSM_UROW + (tok & 63) * 32); dst[0] = v0; dst[1] = v1; }
    __syncthreads();
    {
        int ws2 = wave_s; asm volatile("" : "+s"(ws2));
        const int nb = ws2 & 3, kh = ws2 >> 2; f32x16_t acc;
#pragma unroll
        for (int r = 0; r < 16; ++r) acc[r] = 0.f;
        {
            gcu8 bp = Tg + ((size_t)(65 + nb * 64 + 32 * kh) * 64 + lane) * 16; const LAS unsigned char* ap = lds + n * SSM_UROW + (32 * kh) * 32 + 16 * h;
            bf16x8_t cur[8], nxt[8];
#pragma unroll
            for (int i = 0; i < 8; ++i) cur[i] = *(const GAS bf16x8_t*)(bp + i * 1024);
#pragma unroll
            for (int bt = 0; bt < 4; ++bt) {
                if (bt < 3) {
#pragma unroll
                    for (int i = 0; i < 8; ++i) nxt[i] = *(const GAS bf16x8_t*)(bp + (bt * 8 + 8 + i) * 1024); }
#pragma unroll
                for (int i = 0; i < 8; ++i) { const bf16x8_t a = *(const LAS bf16x8_t*)(ap + (bt * 8 + i) * 32); acc = MFMA32(a, cur[i], acc); }
#pragma unroll
                for (int i = 0; i < 8; ++i) cur[i] = nxt[i];
            }
        }
        LAS float* SL = (LAS float*)(lds + SSM_SL_OFF);
        if (kh == 0) {
#pragma unroll
            for (int r = 0; r < 16; ++r) SL[crow16(r, h) * 128 + 32 * nb + n] = acc[r]; }
        __syncthreads();
        if (kh == 1) {
#pragma unroll
            for (int r = 0; r < 16; ++r) SL[crow16(r, h) * 128 + 32 * nb + n] += acc[r]; }
        __syncthreads();
        if (wave_s == 0) {
            const float ar = AP[(size_t)((g * 64 + lane) * 65 + 64) * 2], ai = AP[(size_t)((g * 64 + lane) * 65 + 64) * 2 + 1];
            float hr = 0.f, hi = 0.f;
            for (int c = 0; c < 32; ++c) {
                LAS bf16_t* hp = (LAS bf16_t*)(lds + SSM_HP_OFF + c * SSM_HROW); hp[lane] = f2bf(hr); hp[64 + lane] = f2bf(hi);
                const float sr = SL[c * 128 + lane], si = SL[c * 128 + 64 + lane];
                const float nr = ar * hr - ai * hi + sr, ni = ar * hi + ai * hr + si; hr = nr; hi = ni;
            }
        }
        __syncthreads();
    }
    for (int q = 0; q < 4; ++q) {
        const int nb = (q == 0) ? wave_s : (q == 1) ? 15 - wave_s : (q == 2) ? 16 + wave_s : 31 - wave_s;
        f32x16_t acc;
#pragma unroll
        for (int r = 0; r < 16; ++r) acc[r] = 0.f;
        const int ns = 2 * nb + 2, total = ns + 8;
        {
            gcu8 tp = Tg + ((size_t)(2 * nb + 1) * 64 + lane) * 16, cp = Tg + ((size_t)(321 + nb * 8) * 64 + lane) * 16;
            const LAS unsigned char* ua = lds + n * SSM_UROW + 16 * h; const LAS unsigned char* ha = lds + SSM_HP_OFF + n * SSM_HROW + 16 * h;
#define SSM_BLOAD(dst, k) do { const int k_ = (k); if (k_ < total) dst = *(const GAS bf16x8_t*)(k_ < ns ? tp - (size_t)k_ * 1024 : cp + (size_t)(k_ - ns) * 1024); } while (0)
            bf16x8_t cur[8], nxt[8];
#pragma unroll
            for (int i = 0; i < 8; ++i) SSM_BLOAD(cur[i], i);
            for (int base = 0; base < total; base += 8) {
#pragma unroll
                for (int i = 0; i < 8; ++i) SSM_BLOAD(nxt[i], base + 8 + i);
#pragma unroll
                for (int i = 0; i < 8; ++i) { const int k = base + i;
                    if (k < total) { const bf16x8_t a = *(const LAS bf16x8_t*)(k < ns ? ua + k * 32 : ha + (k - ns) * 32); acc = MFMA32(a, cur[i], acc); } }
#pragma unroll
                for (int i = 0; i < 8; ++i) cur[i] = nxt[i];
            }
#undef SSM_BLOAD
        }
        const int t = 2 * nb + (n >> 4), j = n & 15; const float dsk = d_skip[g * 16 + j];
#pragma unroll
        for (int r = 0; r < 16; ++r) { const int c = crow16(r, h);
            const float u = bf2f(*(const LAS bf16_t*)(lds + c * SSM_UROW + (t * 16 + j) * 2));
            Z[(size_t)(b * S + c * 64 + t) * 256 + g * 16 + j] = f2bf(gelu_tanh(acc[r] + dsk * u)); }
    }
    __syncthreads();
}

typedef short s16x4_t __attribute__((ext_vector_type(4)));
typedef float f32x2_t __attribute__((ext_vector_type(2))); typedef __bf16 bf16x2_t __attribute__((ext_vector_type(2)));
__device__ __forceinline__ unsigned cvtpk(float lo, float hi) { f32x2_t v = {lo, hi}; bf16x2_t b = __builtin_convertvector(v, bf16x2_t); return __builtin_bit_cast(unsigned, b); }
__device__ __forceinline__ int swap32_add(int v) { auto rr = __builtin_amdgcn_permlane32_swap((unsigned)v, (unsigned)v, false, false); return (int)(rr[0] + rr[1]); }
__device__ __forceinline__ unsigned swap32_or(unsigned v) { auto rr = __builtin_amdgcn_permlane32_swap(v, v, false, false); return rr[0] | rr[1]; }
__device__ __forceinline__ float swap32_max(float v) { auto rr = __builtin_amdgcn_permlane32_swap(__float_as_uint(v), __float_as_uint(v), false, false); return fmaxf(__uint_as_float(rr[0]), __uint_as_float(rr[1])); }
__device__ __forceinline__ float swap32_addf(float v) { auto rr = __builtin_amdgcn_permlane32_swap(__float_as_uint(v), __float_as_uint(v), false, false); return __uint_as_float(rr[0]) + __uint_as_float(rr[1]); }
__device__ __forceinline__ int wave_sum_dpp(int v) {
    v += __builtin_amdgcn_update_dpp(0, v, 0x111, 0xf, 0xf, false);
    v += __builtin_amdgcn_update_dpp(0, v, 0x112, 0xf, 0xf, false);
    v += __builtin_amdgcn_update_dpp(0, v, 0x114, 0xf, 0xf, false);
    v += __builtin_amdgcn_update_dpp(0, v, 0x118, 0xf, 0xf, false);
    v += __builtin_amdgcn_update_dpp(0, v, 0x142, 0xa, 0xf, false);
    v += __builtin_amdgcn_update_dpp(0, v, 0x143, 0xc, 0xf, false);
    return __builtin_amdgcn_readlane(v, 63);
}
template <int K> __device__ __forceinline__ unsigned swz_xor_u(unsigned v) { return (unsigned)__builtin_amdgcn_ds_swizzle((int)v, (K << 10) | 0x1F); }
__device__ __forceinline__ unsigned wave_min_u(unsigned v) { v = min(v, swz_xor_u<1>(v)); v = min(v, swz_xor_u<2>(v)); v = min(v, swz_xor_u<4>(v)); v = min(v, swz_xor_u<8>(v)); v = min(v, swz_xor_u<16>(v));
    auto rr = __builtin_amdgcn_permlane32_swap(v, v, false, false); return (unsigned)__builtin_amdgcn_readfirstlane((int)min(rr[0], rr[1])); }
__device__ __forceinline__ unsigned wave_max_u(unsigned v) { v = max(v, swz_xor_u<1>(v)); v = max(v, swz_xor_u<2>(v)); v = max(v, swz_xor_u<4>(v)); v = max(v, swz_xor_u<8>(v)); v = max(v, swz_xor_u<16>(v));
    auto rr = __builtin_amdgcn_permlane32_swap(v, v, false, false); return (unsigned)__builtin_amdgcn_readfirstlane((int)max(rr[0], rr[1])); }
__device__ __forceinline__ s16x4_t tr_read(const LAS unsigned char* p) { typedef short v4i16_t __attribute__((ext_vector_type(4))); return __builtin_bit_cast(s16x4_t, __builtin_amdgcn_ds_read_tr16_b64_v4i16((LAS v4i16_t*)p)); }
constexpr int AT_QIROW = 528, AT_KROW = 144, AT_VROW = 192, AT_GTM = 0, AT_KT = AT_GTM + 16384, AT_VT = AT_KT + 2 * 64 * AT_KROW, AT_QL = AT_VT + 2 * 64 * AT_VROW,
              AT_LDS = AT_QL + 512 * AT_KROW,
              AT_QI = 16384, AT_WI = AT_QI + 64 * AT_QIROW, AT_RD = AT_WI + 1024, AT_RDROW = 521, AT_P1END = AT_RD + 32 * AT_RDROW * 4;
static_assert(AT_LDS <= 143360 && AT_P1END <= 143360, "attention LDS");
static_assert(AT_LDS <= 143360, "attention LDS");
#define AT_BAR() do { asm volatile("s_waitcnt lgkmcnt(0)" ::: "memory"); __builtin_amdgcn_s_barrier(); asm volatile("" ::: "memory"); } while (0)
__device__ __forceinline__ void attn_unit(LAS unsigned char* lds, gcb16 P, gb16 AO, int b, int c, int wave_s) {
    gcb16 Pb = P + (size_t)b * S * PC;
    const int nkb = 2 * (c + 1);
    LAS unsigned* GTM = (LAS unsigned*)(lds + AT_GTM); LAS unsigned* RD = (LAS unsigned*)(lds + AT_RD); LAS float* WI = (LAS float*)(lds + AT_WI);
    AT_BAR();
    {
    const int lane = lane_id_here(), tid = wave_s * 64 + lane, n = lane & 31, h = lane >> 5;
    if (c < 4) {
        for (int e = tid; e < 64 * 64; e += 512) GTM[e] = 0xffffffffu;
    } else {
        { const int row = tid >> 3, pc = tid & 7; const GAS u32x4* src = (const GAS u32x4*)(Pb + (size_t)(c * 64 + row) * PC + PC_QI + pc * 32);
#pragma unroll
          for (int i = 0; i < 4; ++i) *(LAS u32x4*)(lds + AT_QI + row * AT_QIROW + pc * 64 + i * 16) = src[i];
          if (tid < 256) WI[tid] = bf2f(Pb[(size_t)(c * 64 + (tid >> 2)) * PC + PC_WI + (tid & 3)]); }
        AT_BAR();
        for (int rd = 0; rd < 2; ++rd) {
            const int qt = 32 * rd + n; int hq = 4 * h; asm volatile("" : "+v"(hq));
            unsigned sc[8][16];
            bf16x8_t kfn[4]; gcb16 kpn = Pb + (size_t)(wave_s * 32 + n) * PC + PC_KI + 8 * h;
            if (wave_s < nkb) {
#pragma unroll
                for (int s = 0; s < 4; ++s) kfn[s] = *(const GAS bf16x8_t*)(kpn + 16 * s); }
#pragma unroll
            for (int kbi = 0; kbi < 8; ++kbi) {
                const int kb = wave_s + 8 * kbi;
                if (kb < nkb) {
                    bf16x8_t kf[4];
#pragma unroll
                    for (int s = 0; s < 4; ++s) kf[s] = kfn[s];
                    kpn += (size_t)256 * PC; asm volatile("" : "+v"(kpn));
                    if (kb + 8 < nkb) {
#pragma unroll
                        for (int s = 0; s < 4; ++s) kfn[s] = *(const GAS bf16x8_t*)(kpn + 16 * s); }
                    float score[16];
#pragma unroll
                    for (int r = 0; r < 16; ++r) score[r] = 0.f;
#pragma unroll
                    for (int hh = 0; hh < 4; ++hh) { f32x16_t acc;
#pragma unroll
                        for (int r = 0; r < 16; ++r) acc[r] = 0.f;
#pragma unroll
                        for (int s = 0; s < 4; ++s) { const bf16x8_t qf = *(const LAS bf16x8_t*)(lds + AT_QI + qt * AT_QIROW + (hh * 64 + 16 * s + 8 * h) * 2); acc = MFMA32(kf[s], qf, acc); }
                        const float wv = WI[qt * 4 + hh];
#pragma unroll
                        for (int r = 0; r < 16; ++r) score[r] += wv * fmaxf(acc[r], 0.f); }
#pragma unroll
                    for (int r = 0; r < 16; ++r) sc[kbi][r] = (sortable(score[r]) & 0xfffff800u) | (unsigned)((2047 - kb * 32 - ((r & 3) + 8 * (r >> 2))) - hq);
                } else {
#pragma unroll
                    for (int r = 0; r < 16; ++r) sc[kbi][r] = 0u;
                }
            }
            const int nv = nkb >> 1;
            unsigned kv[4][32];
#pragma unroll
            for (int p = 0; p < 4; ++p) {
                AT_BAR();
#pragma unroll
                for (int q2 = 0; q2 < 2; ++q2) { const int kbi = 2 * p + q2, kb = wave_s + 8 * kbi;
                    if (kb < nkb) {
#pragma unroll
                        for (int r = 0; r < 16; ++r) RD[n * AT_RDROW + (wave_s + 8 * q2) * 32 + (r & 3) + 8 * (r >> 2) + 4 * h] = sc[kbi][r]; } }
                AT_BAR();
#pragma unroll
                for (int j = 0; j < 4; ++j)
#pragma unroll
                    for (int i2 = 0; i2 < 8; ++i2) kv[j][8 * p + i2] = (8 * p + i2 < nv) ? RD[(8 * j + wave_s) * AT_RDROW + lane + 64 * i2] : 0u;
            }
#pragma unroll
            for (int j = 0; j < 4; ++j) {
                unsigned mn = 0xffffffffu, mx = 0u;
#pragma unroll
                for (int i = 0; i < 32; ++i) if (i < nv) { mn = min(mn, kv[j][i]); mx = max(mx, kv[j][i]); }
                unsigned lo_u = wave_min_u(mn), hi_u = wave_max_u(mx); hi_u = hi_u == 0xffffffffu ? hi_u : hi_u + 1u;
                int c_lo = 32 * nkb, c_hi = 0;
                for (int iter = 0; iter < 400 && c_lo != 256 && hi_u - lo_u > 1u; ++iter) {
                    unsigned cand;
                    const float fl = unsortable(lo_u), fh = unsortable(hi_u);
                    const bool plateau = lo_u >= 0x80000000u && hi_u <= 0x80000800u;
                    if (iter == 0 && lo_u < 0x80000800u && hi_u > 0x80000800u) cand = 0x80000800u;
                    else if (iter == 1 && lo_u < 0x80000000u && hi_u > 0x80000000u && hi_u <= 0x80000800u) cand = 0x80000000u;
                    else if (plateau || (iter & 7) == 7 || (iter > 24 && (iter & 1))) cand = lo_u + ((hi_u - lo_u) >> 1);
                    else if (iter < 5 || (iter & 1)) cand = sortable(0.5f * fl + 0.5f * fh);
                    else cand = sortable(fl + (fh - fl) * (((float)(c_lo - 256) + 0.5f) * __builtin_amdgcn_rcpf((float)(c_lo - c_hi))));
                    cand = max(cand, lo_u + 1u); cand = min(cand, hi_u - 1u);
                    cand = (unsigned)__builtin_amdgcn_readfirstlane((int)cand);
                    unsigned ca = 0u, cb = 0u;
#pragma unroll
                    for (int i = 0; i < 32; i += 8) if (i < nv) {
                        unsigned long long m0, m1, m2, m3, m4, m5, m6, m7;
                        asm volatile("v_cmp_ge_u32_e64 %2, %10, %18\n\tv_cmp_ge_u32_e64 %3, %11, %18\n\tv_cmp_ge_u32_e64 %4, %12, %18\n\tv_cmp_ge_u32_e64 %5, %13, %18\n\t"
                                     "v_cmp_ge_u32_e64 %6, %14, %18\n\tv_cmp_ge_u32_e64 %7, %15, %18\n\tv_cmp_ge_u32_e64 %8, %16, %18\n\tv_cmp_ge_u32_e64 %9, %17, %18\n\t"
                                     "v_addc_co_u32_e64 %0, %2, %0, 0, %2\n\tv_addc_co_u32_e64 %1, %3, %1, 0, %3\n\tv_addc_co_u32_e64 %0, %4, %0, 0, %4\n\tv_addc_co_u32_e64 %1, %5, %1, 0, %5\n\t"
                                     "v_addc_co_u32_e64 %0, %6, %0, 0, %6\n\tv_addc_co_u32_e64 %1, %7, %1, 0, %7\n\tv_addc_co_u32_e64 %0, %8, %0, 0, %8\n\tv_addc_co_u32_e64 %1, %9, %1, 0, %9"
                                     : "+v"(ca), "+v"(cb), "=&s"(m0), "=&s"(m1), "=&s"(m2), "=&s"(m3), "=&s"(m4), "=&s"(m5), "=&s"(m6), "=&s"(m7)
                                     : "v"(kv[j][i]), "v"(kv[j][i + 1]), "v"(kv[j][i + 2]), "v"(kv[j][i + 3]), "v"(kv[j][i + 4]), "v"(kv[j][i + 5]), "v"(kv[j][i + 6]), "v"(kv[j][i + 7]), "v"(cand));
                    }
                    const int cnt = wave_sum_dpp((int)(ca + cb));
                    if (cnt >= 256) { lo_u = cand; c_lo = cnt; } else { hi_u = cand; c_hi = cnt; }
                }
                const int qrow = (32 * rd + 8 * j + wave_s) * 64;
#pragma unroll
                for (int i = 0; i < 32; ++i) if (i < nv) { const unsigned long long mm = __ballot(kv[j][i] >= lo_u);
                    if (lane == 0) { GTM[qrow + 2 * i] = (unsigned)mm; GTM[qrow + 2 * i + 1] = (unsigned)(mm >> 32); } }
            }
        }
        AT_BAR();
    }
    }
    const int lane = lane_id_here(), tid = wave_s * 64 + lane, n = lane & 31, h = lane >> 5;
    const float C2 = 0.125f * 1.4426950408889634f;
    bf16x8_t qfe[2]; float nsl16[2], m_run[2], l_run[2]; int tql[2]; f32x16_t O[2][2];
#pragma unroll
    for (int i = 0; i < 8; ++i) { const int e = tid + 512 * i, R = e >> 3, pc = e & 7;
        *(LAS u32x4*)(lds + AT_QL + R * AT_KROW + pc * 16) = *(const GAS u32x4*)(Pb + (size_t)(c * 64 + (R >> 3)) * PC + PC_Q + (R & 7) * 64 + pc * 8); }
#pragma unroll
    for (int rb = 0; rb < 2; ++rb) { const int R = 64 * wave_s + 32 * rb + n, tl = R >> 3, hd = R & 7; tql[rb] = tl;
        { int cq = c; asm volatile("" : "+s"(cq)); const float sl8 = exp2f((float)(2 - hd));
          const unsigned q0 = __float_as_uint(64.f * sl8) >> 16, q1 = __float_as_uint(sl8) >> 16, q2 = __float_as_uint(-64.f * sl8 * (float)cq) >> 16, q3 = __float_as_uint(-sl8 * (float)tl) >> 16;
          const u32x4 qe = {h == 0 ? (q0 | (q1 << 16)) : 0u, h == 0 ? (q2 | (q3 << 16)) : 0u, 0u, 0u}; qfe[rb] = __builtin_bit_cast(bf16x8_t, qe); nsl16[rb] = -2.f * sl8; }
        m_run[rb] = -1.0e30f; l_run[rb] = 0.f;
#pragma unroll
        for (int db = 0; db < 2; ++db)
#pragma unroll
            for (int r = 0; r < 16; ++r) O[rb][db][r] = 0.f; }
    const int skey = tid >> 3, sch = tid & 7;
    u32x4 stK, stV;
    { gcb16 kp = Pb + (size_t)skey * PC + PC_K + sch * 8; stK = *(const GAS u32x4*)kp; stV = *(const GAS u32x4*)(kp + 64); }
    *(LAS u32x4*)(lds + AT_KT + skey * AT_KROW + sch * 16) = stK; *(LAS u32x4*)(lds + AT_VT + skey * AT_VROW + sch * 16) = stV;
    AT_BAR();
    const int gl = lane >> 4, i16 = lane & 15, trq = i16 >> 2, trp = i16 & 3;
    bf16x8_t qf[2][4];
#pragma unroll
    for (int rb = 0; rb < 2; ++rb)
#pragma unroll
        for (int s = 0; s < 4; ++s) qf[rb][s] = *(const LAS bf16x8_t*)(lds + AT_QL + (64 * wave_s + 32 * rb + n) * AT_KROW + (16 * s + 8 * h) * 2);
    for (int jt = 0; jt <= c; ++jt) {
        const int buf = jt & 1;
        if (jt < c) { gcb16 kp = Pb + (size_t)((jt + 1) * 64 + skey) * PC + PC_K + sch * 8; stK = *(const GAS u32x4*)kp; stV = *(const GAS u32x4*)(kp + 64); }
        const LAS unsigned char* KT = lds + AT_KT + buf * 64 * AT_KROW; const LAS unsigned char* VT = lds + AT_VT + buf * 64 * AT_VROW;
#pragma unroll 1
        for (int kb2 = 0; kb2 < 2; ++kb2) {
            bf16x8_t kf[4], vf[2][2];
            const u32x4 ke = {h == 0 ? ((__float_as_uint((float)jt) >> 16) | (__float_as_uint((float)(32 * kb2 + n)) & 0xffff0000u)) : 0u, h == 0 ? 0x3f803f80u : 0u, 0u, 0u};
            const bf16x8_t kfe = __builtin_bit_cast(bf16x8_t, ke);
#pragma unroll
            for (int s = 0; s < 4; ++s) kf[s] = *(const LAS bf16x8_t*)(KT + (32 * kb2 + n) * AT_KROW + (16 * s + 8 * h) * 2);
#pragma unroll
            for (int db = 0; db < 2; ++db)
#pragma unroll
                for (int s2 = 0; s2 < 2; ++s2) { const LAS unsigned char* vb = VT + (32 * kb2 + 16 * s2 + 4 * h + trq) * AT_VROW + (32 * db + 16 * (gl & 1) + 4 * trp) * 2;
                    const s16x4_t lo = tr_read(vb), hi = tr_read(vb + 8 * AT_VROW);
                    vf[db][s2] = (bf16x8_t){lo[0], lo[1], lo[2], lo[3], hi[0], hi[1], hi[2], hi[3]}; }
            f32x16_t sacc[2]; float sv[2][16], mt[2];
#pragma unroll
            for (int rb = 0; rb < 2; ++rb)
#pragma unroll
                for (int r = 0; r < 16; ++r) sacc[rb][r] = 0.f;
#pragma unroll
            for (int s = 0; s < 4; ++s)
#pragma unroll
                for (int rb = 0; rb < 2; ++rb) sacc[rb] = MFMA32(kf[s], qf[rb][s], sacc[rb]);
#pragma unroll
            for (int rb = 0; rb < 2; ++rb) sacc[rb] = MFMA32(kfe, qfe[rb], sacc[rb]);
            if (jt == c) {
#pragma unroll
                for (int rb = 0; rb < 2; ++rb) { const float fd = (float)(32 * kb2 + 4 * h - tql[rb]);
#pragma unroll
                    for (int r = 0; r < 16; ++r) sacc[rb][r] += nsl16[rb] * fmaxf(fd + (float)((r & 3) + 8 * (r >> 2)), 0.f); } }
#pragma unroll
            for (int rb = 0; rb < 2; ++rb) { const unsigned mw = GTM[tql[rb] * 64 + 2 * jt + kb2] >> (4 * h); float m_ = -INFINITY;
#pragma unroll
                for (int r = 0; r < 16; ++r) { const int sh = (r & 3) + 8 * (r >> 2);
                    const int tmask = __builtin_amdgcn_sbfe((int)mw, sh, 1);
                    sv[rb][r] = __uint_as_float((__float_as_uint(sacc[rb][r]) & (unsigned)tmask) | (0xff800000u & ~(unsigned)tmask)); m_ = fmaxf(m_, sv[rb][r]); }
                mt[rb] = swap32_max(m_) * C2; }
            if (__any((mt[0] > m_run[0] + 8.0f) | (mt[1] > m_run[1] + 8.0f))) {
#pragma unroll
                for (int rb = 0; rb < 2; ++rb) { const float mn = fmaxf(m_run[rb], mt[rb]), al = __builtin_amdgcn_exp2f(m_run[rb] - mn); m_run[rb] = mn; l_run[rb] *= al;
#pragma unroll
                    for (int db = 0; db < 2; ++db)
#pragma unroll
                        for (int r = 0; r < 16; ++r) O[rb][db][r] *= al; } }
#pragma unroll
            for (int rb = 0; rb < 2; ++rb) {
                float ps = 0.f; unsigned pw[8]; const float nm = -m_run[rb];
#pragma unroll
                for (int r = 0; r < 16; r += 2) { const float p0 = __builtin_amdgcn_exp2f(fmaf(sv[rb][r], C2, nm)), p1 = __builtin_amdgcn_exp2f(fmaf(sv[rb][r + 1], C2, nm)); ps += p0 + p1; pw[r >> 1] = cvtpk(p0, p1); }
                l_run[rb] += ps;
#pragma unroll
                for (int s2 = 0; s2 < 2; ++s2) { const u32x4 pk = {pw[4 * s2], pw[4 * s2 + 1], pw[4 * s2 + 2], pw[4 * s2 + 3]}; const bf16x8_t pf = __builtin_bit_cast(bf16x8_t, pk);
#pragma unroll
                    for (int db = 0; db < 2; ++db) O[rb][db] = MFMA32(vf[db][s2], pf, O[rb][db]); }
            }
        }
        if (jt < c) { const int nb_ = buf ^ 1; *(LAS u32x4*)(lds + AT_KT + nb_ * 64 * AT_KROW + skey * AT_KROW + sch * 16) = stK; *(LAS u32x4*)(lds + AT_VT + nb_ * 64 * AT_VROW + skey * AT_VROW + sch * 16) = stV; }
        AT_BAR();
    }
#pragma unroll
    for (int rb = 0; rb < 2; ++rb) { const float inv = 1.0f / swap32_addf(l_run[rb]); const int R = 64 * wave_s + 32 * rb + n, tl = R >> 3, hd = R & 7;
        gb16 op = AO + (size_t)(b * S + c * 64 + tl) * 512 + hd * 64 + 4 * h;
#pragma unroll
        for (int db = 0; db < 2; ++db)
#pragma unroll
            for (int g4 = 0; g4 < 4; ++g4) { u32x2v w; w.x = cvtpk(O[rb][db][4 * g4] * inv, O[rb][db][4 * g4 + 1] * inv); w.y = cvtpk(O[rb][db][4 * g4 + 2] * inv, O[rb][db][4 * g4 + 3] * inv);
                *(GAS u32x2v*)(op + 32 * db + 8 * g4) = w; } }
}


struct SrcId { __device__ int operator()(int r) const { return r; } };
struct SrcWin { __device__ int operator()(int r) const { return refcol_of(r); } };
template <int HALFN> struct SrcPair { __device__ int operator()(int r) const { const int t = r >> 8, i = r & 255; return i < 128 ? 128 * t + i : HALFN + 128 * t + (i - 128); } };
template <class SC>
__device__ __forceinline__ void transpose_item(gcf32 W, int K, int N, gb16 WT, SC sc, LAS float* scr  , int item, int lane) {
    const int nk = K / 64, kb = item % nk, nb = item / nk, k0 = 64 * kb, n0 = 64 * nb;
    const int c4 = 4 * (lane & 15), col = sc(n0 + c4);
    f32x4 tv[16];
#pragma unroll
    for (int i = 0; i < 16; ++i) { const int kk = 4 * i + (lane >> 4); tv[i] = (f32x4){0.f, 0.f, 0.f, 0.f}; if (col >= 0) tv[i] = *(const GAS f32x4*)(W + (size_t)(k0 + kk) * N + col); }
#pragma unroll
    for (int i = 0; i < 16; ++i) { const int kk = 4 * i + (lane >> 4); LAS float* d = scr + kk * 65 + c4; d[0] = tv[i][0]; d[1] = tv[i][1]; d[2] = tv[i][2]; d[3] = tv[i][3]; }
    asm volatile("s_waitcnt lgkmcnt(0)" ::: "memory");
    const int c = lane & 7;
#pragma unroll
    for (int j = 0; j < 8; ++j) { const int n = (lane >> 3) + 8 * j; const LAS float* s = scr + (8 * c) * 65 + n;
        u32x4 o; o.x = pg8::cvt_pk_bf16(s[0 * 65], s[1 * 65]); o.y = pg8::cvt_pk_bf16(s[2 * 65], s[3 * 65]); o.z = pg8::cvt_pk_bf16(s[4 * 65], s[5 * 65]); o.w = pg8::cvt_pk_bf16(s[6 * 65], s[7 * 65]);
        *(GAS u32x4*)(WT + (size_t)(n0 + n) * K + k0 + 8 * c) = o; }
    asm volatile("s_waitcnt lgkmcnt(0)" ::: "memory");
}
template <int I> __device__ __forceinline__ gcf32 KIN();
__device__ __forceinline__ void ph_weights(gu8 ws, LAS float* scr, int gw, int lane) {
    constexpr int I_WIN = 16 * (PC / 64), I_WFI = 16 * (2 * DFF / 64), I_WFO = (DFF / 64) * (D / 64), I_WO = 16 * (D / 64), I_WC = 4 * (D / 64), I_WGLU = 4 * (2 * D / 64), I_WAO = 8 * (D / 64);
    constexpr int I_WMOD = 16 * (6 * D / 64), I_LAYER = I_WMOD + I_WIN + I_WFI + I_WFO + I_WO + I_WC + I_WGLU + I_WAO;
    for (int it = gw; it < NL * I_LAYER; it += NGW) {
        const int l = it / I_LAYER; int r = it % I_LAYER; gu8 wl = ws + WS_W + (size_t)l * WS_W_LAYER;
        if (r < I_WMOD) { transpose_item(KIN<2>() + (size_t)l * D * 6 * D, D, 6 * D, (gb16)(ws + WS_WMODT) + (size_t)l * 6 * D * D, SrcId{}, scr, r, lane); continue; } r -= I_WMOD;
        if (r < I_WIN) { transpose_item(KIN<5>() + (size_t)l * D * DIN, D, DIN, (gb16)(wl + WO_WIN), SrcWin{}, scr, r, lane); continue; } r -= I_WIN;
        if (r < I_WFI) { transpose_item(KIN<21>() + (size_t)l * D * 2 * DFF, D, 2 * DFF, (gb16)(wl + WO_WFI), SrcPair<DFF>{}, scr, r, lane); continue; } r -= I_WFI;
        if (r < I_WFO) { transpose_item(KIN<22>() + (size_t)l * DFF * D, DFF, D, (gb16)(wl + WO_WFO), SrcId{}, scr, r, lane); continue; } r -= I_WFO;
        if (r < I_WO) { transpose_item(KIN<19>() + (size_t)l * D * D, D, D, (gb16)(wl + WO_WO), SrcId{}, scr, r, lane); continue; } r -= I_WO;
        if (r < I_WC) { transpose_item(KIN<8>() + (size_t)l * 256 * D, 256, D, (gb16)(wl + WO_WC), SrcId{}, scr, r, lane); continue; } r -= I_WC;
        if (r < I_WGLU) { transpose_item(KIN<17>() + (size_t)l * 256 * 2 * D, 256, 2 * D, (gb16)(wl + WO_WGLU), SrcPair<D>{}, scr, r, lane); continue; } r -= I_WGLU;
        transpose_item(KIN<18>() + (size_t)l * 512 * D, 512, D, (gb16)(wl + WO_WAO), SrcId{}, scr, r, lane);
    }
}
template <class Epi>
__device__ __forceinline__ void run_gemm(LAS unsigned char* ring, gcb16 A, int lda, gcb16 Bt, int N, int K, const Epi& E, int wave_s) {
    pg8::Gemm g{(const bf16_t*)A, (const bf16_t*)Bt, M, N, K, lda}; const int bx_ = (int)blockIdx.x; __builtin_assume(bx_ >= 0 && bx_ < GRID); pg8::StaticOrder S; S.init(M, N, GRID, bx_);
    pg8::gemm_phase<Epi, pg8::StaticOrder, true, true>(ring, g, S, E, wave_s);
}
struct PairedOrder : pg8::StaticOrder {
    __device__ __forceinline__ bool next(int j, Unit& u) const { Unit v; if (!pg8::StaticOrder::next(j >> 1, v)) return false; u.pm = v.pm; u.pn = 2 * v.pn + (j & 1); return true; }
};
template <class Epi>
__device__ __forceinline__ void run_gemm_paired(LAS unsigned char* ring, gcb16 A, int lda, gcb16 Bt, int K, const Epi& E, int wave_s) {
    pg8::Gemm g{(const bf16_t*)A, (const bf16_t*)Bt, M, 2 * D, K, lda}; const int bx_ = (int)blockIdx.x; __builtin_assume(bx_ >= 0 && bx_ < GRID); PairedOrder S; S.init(M, D, GRID, bx_);
    pg8::gemm_phase<Epi, PairedOrder, true, true>(ring, g, S, E, wave_s);
}
template <class Epi>
__device__ __forceinline__ void run_gemm16(LAS unsigned char* ring, gcb16 A, gcb16 Bt, int N, const Epi& E, int cidx, int wave_s) {
    if (cidx < 0 || cidx >= N / 256) return;
    pg8::Gemm g{(const bf16_t*)A, (const bf16_t*)Bt, 256, N, D, D}; pg8::StaticOrder S; S.init(256, N, GRID, cidx);
    pg8::gemm_phase<Epi, pg8::StaticOrder, true, true>(ring, g, S, E, wave_s);
}

template <int I> __device__ __forceinline__ gcf32 KIN() {
    auto kp = __builtin_amdgcn_kernarg_segment_ptr(); unsigned long long v;
    asm volatile("s_load_dwordx2 %0, %1, %2\n\ts_waitcnt lgkmcnt(0)" : "=s"(v) : "s"(kp), "i"(8 * I) : "memory");
    return (gcf32)v;
}
__global__ void __launch_bounds__(NTHREADS, 2) mk_fwd(Args a) {
    extern __shared__ __attribute__((aligned(16))) unsigned char lds_raw[];
    LAS unsigned char* ring = (LAS unsigned char*)lds_raw;
    volatile LAS unsigned* MISC = (volatile LAS unsigned*)((LAS unsigned char*)lds_raw + MISC_OFF);
    const int wave_s = __builtin_amdgcn_readfirstlane(threadIdx.x >> 6);
    { const unsigned bx_ = blockIdx.x; __builtin_assume(bx_ < GRID); } __builtin_assume(wave_s >= 0 && wave_s < NWAVES);
#define IDS const int lane = lane_id_here(), gw = blockIdx.x * NWAVES + wave_s; __builtin_assume(gw >= 0 && gw < NGW); __builtin_assume(lane >= 0 && lane < 64); (void)lane; (void)gw;
    if (wave_s == 0) { const int l0 = lane_id_here(); if (l0 < 32) MISC[l0] = 0u; }
    __syncthreads();
    gu8 ws = (gu8)KIN<25>();
    XcdBarrier bar = xcd_barrier_post((unsigned*)(ws + WS_CTL) + 1024, MISC + 8, wave_s);
#define XB_ ((gb16)KIN<24>())
#define X_ ((gf32)(ws + WS_P + 176 * MiB))
#define MOD_ ((gf32)(ws + WS_MOD))
#define H_ ((gb16)(ws + WS_H))
#define CONVA_ ((gb16)(ws + WS_CONVA))
#define Z_ ((gb16)(ws + WS_Z))
#define AO_ ((gb16)(ws + WS_AO))
#define P_ ((gb16)(ws + WS_P))
#define ACT_ ((gb16)(ws + WS_P))
#define WT_(l, off) ((gcb16)(ws + WS_W + (size_t)(l) * WS_W_LAYER + (off)))
#define A16_(i) ((gb16)(ws + WS_A16) + (size_t)(i) * 256 * D)
    { IDS; ph_a16(KIN<1>(), A16_(0), (gu64)(ws + WS_SSQ), gw, lane); }
    { IDS; ph_ssm_params(KIN<9>(), KIN<10>(), KIN<11>(), KIN<12>(), KIN<13>(), (gf32)(ws + WS_SSMP), (gf32)(ws + WS_AP), gw, lane); }
    { IDS; ph_ssm_kd(KIN<9>(), KIN<10>(), KIN<11>(), KIN<12>(), KIN<13>(), KIN<14>(), KIN<15>(), (gf32)(ws + WS_KD), (LAS float*)(ring + wave_s * 16640), gw, lane); }
    { IDS; ph_weights(ws, (LAS float*)(ring + wave_s * 16640), gw, lane); }
    xcd_barrier(bar, wave_s);
    { const int bxv = (int)blockIdx.x;
      for (int l = 0; l < NL; ++l) run_gemm16(ring, A16_(0), (gcb16)(ws + WS_WMODT) + (size_t)l * 6 * D * D, 6 * D, EpiMod{MOD_ + (size_t)l * NB * 6 * D, KIN<3>() + l * 6 * D, A16_(1 + 2 * l), A16_(2 + 2 * l)}, bxv - 128 * l, wave_s); }
    { IDS; ph_ssm_frags(KIN<14>(), KIN<15>(), (gcf32)(ws + WS_SSMP), (gcf32)(ws + WS_AP), (gcf32)(ws + WS_KD), ws + WS_SSMT, gw, lane); }
    xcd_barrier(bar, wave_s);
    { const int bxv = (int)blockIdx.x;
      for (int l = 0; l < NL; ++l) {
          run_gemm16(ring, A16_(1 + 2 * l), WT_(l, WO_WIN), PC, EpiBias{(gf32)(ws + WS_BIAS) + (size_t)l * BIAS_LAYER, PC, KIN<6>() + l * 3 * D, PC_G}, bxv - 128 * l, wave_s);
          run_gemm16(ring, A16_(2 + 2 * l), WT_(l, WO_WFI), 2 * DFF, EpiBias{(gf32)(ws + WS_BIAS) + (size_t)l * BIAS_LAYER + NB * PC, 2 * DFF, (gcf32)nullptr, 0}, bxv - 128 * l - 64, wave_s); } }
    { const int bxv = (int)blockIdx.x, q4 = bxv >> 6, r64 = bxv & 63, ng = (q4 & 1) ? 22 : 20;
      if (r64 >= ng) { const int rank = q4 * 64 - (q4 >> 1) * 42 - (q4 & 1) * 20 + (r64 - ng); const int lane = lane_id_here(); ph_h0(KIN<0>(), KIN<4>(), MOD_, D, H_, (gu64)(ws + WS_SSQ), rank * NWAVES + wave_s, 172 * NWAVES, lane); } }
    xcd_barrier(bar, wave_s);
#define SSQ_(i) ((gu64)(ws + WS_SSQ) + (size_t)(i) * M)
#define MODL_(l) (MOD_ + (size_t)(l) * NB * 6 * D)
#define BIAS_(l) ((gcf32)(ws + WS_BIAS) + (size_t)(l) * BIAS_LAYER)
    for (int l = 0; l < NL; ++l) {
        run_gemm(ring, H_, D, WT_(l, WO_WIN), PC, D, EpiInproj{P_, BIAS_(l), SSQ_(2 * l)}, wave_s);
        xcd_barrier(bar, wave_s);
        { IDS; ph_conv(P_, KIN<7>() + l * 768, CONVA_, gw, lane); }
        { const int v = (blockIdx.x & 7) * 32 + (blockIdx.x >> 3);
          ssm_fast_item(ring, P_, ws + WS_SSMT + (size_t)l * SSMT_LAYER, (gcf32)(ws + WS_AP) + (size_t)l * 1024 * 65 * 2, KIN<16>() + l * 256, Z_, v >> 4, v & 15, wave_s);
          attn_unit(ring, P_, AO_, v >> 4, 31 - (v & 15), wave_s); attn_unit(ring, P_, AO_, v >> 4, v & 15, wave_s); }
        xcd_barrier(bar, wave_s);
        run_gemm_paired(ring, Z_, 256, WT_(l, WO_WGLU), 256, EpiGlu{P_}, wave_s);
        run_gemm(ring, CONVA_, 256, WT_(l, WO_WC), D, 256, EpiMixAcc{P_, PC_G}, wave_s);
        run_gemm(ring, AO_, 512, WT_(l, WO_WAO), D, 512, EpiMixAcc{P_, PC_G + 2 * D}, wave_s);
        xcd_barrier(bar, wave_s);
        run_gemm(ring, P_, PC, WT_(l, WO_WO), D, D, EpiRes{(l == 0) ? KIN<0>() : (gcf32)nullptr, (l == 0) ? (gcb16)nullptr : (gcb16)XB_, (gf32)nullptr, XB_, MODL_(l) + 2 * D, SSQ_(2 * l + 1), H_, KIN<20>() + l * D, MODL_(l) + 4 * D}, wave_s);
        xcd_barrier(bar, wave_s);
        run_gemm(ring, H_, D, WT_(l, WO_WFI), 2 * DFF, D, EpiFfnIn{ACT_, BIAS_(l) + NB * PC, SSQ_(2 * l + 1)}, wave_s);
        xcd_barrier(bar, wave_s);
        run_gemm(ring, ACT_, DFF, WT_(l, WO_WFO), D, DFF, EpiRes{(gcf32)nullptr, XB_, (l + 1 < NL) ? (gf32)nullptr : X_, (l + 1 < NL) ? XB_ : (gb16)nullptr, MODL_(l) + 5 * D, SSQ_(2 * l + 2), (l + 1 < NL) ? H_ : (gb16)nullptr, KIN<4>() + (l + 1 < NL ? (l + 1) * D : 0), MODL_(l + 1 < NL ? l + 1 : l) + D}, wave_s);
        xcd_barrier(bar, wave_s);
    }
    { IDS; ph_final_norm(X_, (gf32)KIN<24>(), KIN<23>(), SSQ_(2 * NL), gw, lane); }
}
}

extern "C" void kernel_launch(void* const* d_in, const int* in_sizes, int n_in, void* d_out, int out_size, void* d_ws, size_t ws_size, hipStream_t stream) {
    static int ok = 0;
    if (ok == 0) {
        int dev = 0, cus = 0;
        if (n_in != 24 || ws_size < WS_END || hipGetDevice(&dev) != hipSuccess || hipDeviceGetAttribute(&cus, hipDeviceAttributeMultiprocessorCount, dev) != hipSuccess || cus != GRID) {
            fprintf(stderr, "kernel_launch: unexpected configuration (n_in %d, ws %zu, CUs %d)\n", n_in, ws_size, cus); ok = -1; return; }
        if (hipFuncSetAttribute((const void*)mk_fwd, hipFuncAttributeMaxDynamicSharedMemorySize, LDS_BYTES) != hipSuccess) { fprintf(stderr, "kernel_launch: hipFuncSetAttribute failed\n"); ok = -1; return; }
        ok = 1;
    }
    if (ok < 0) return;
    (void)hipMemsetAsync((char*)d_ws + WS_CTL, 0, CTL_ZERO_BYTES, stream);
    Args a{};
    for (int i = 0; i < 24; ++i) a.in[i] = (const float*)d_in[i];
    a.out = (float*)d_out; a.ws = (unsigned char*)d_ws;
    hipLaunchKernelGGL(mk_fwd, dim3(GRID), dim3(NTHREADS), LDS_BYTES, stream, a);
}
```

```cpp
#include <hip/hip_runtime.h>
#include <stdint.h>
#include <math.h>
#include <stdio.h>

namespace {
constexpr int D = 1024, NB = 16, S = 2048, M = NB * S, NL = 2;
constexpr int DIN = 5060, PC = 5120, DFF = 2816;
constexpr int PC_CONV = 0, PC_SSM = 768, PC_Q = 1024, PC_K = 1536, PC_V = 1600, PC_KI = 1664, PC_WI = 1728, PC_QI = 1792, PC_G = 2048;

constexpr size_t MiB = 1u << 20;
constexpr size_t WS_CTL = 0, CTL_ZERO_BYTES = 704 * 1024;
constexpr size_t WS_GBAR = 576 * 1024;
constexpr size_t WS_CACT = 64 * 1024;
constexpr size_t WS_SSMP = 256 * 1024;
constexpr int SSMP_LAYER = 2048 + 32768;
constexpr size_t WS_MOD = 1 * MiB;
constexpr size_t WS_H = 2 * MiB;
constexpr size_t WS_CONVA = WS_H;
constexpr size_t WS_Z = WS_H + 16 * MiB;
constexpr size_t WS_AO = WS_H + 32 * MiB;
constexpr size_t WS_P = 66 * MiB;
constexpr size_t WS_W = 386 * MiB, WS_W_LAYER = 32 * MiB;
constexpr size_t WO_WIN = 0, WO_WFI = 10 * MiB, WO_WFO = 21 * MiB, WO_WO = 26 * MiB + 512 * 1024, WO_WC = 28 * MiB + 512 * 1024, WO_WGLU = 29 * MiB, WO_WAO = 30 * MiB;
constexpr size_t WS_AP = 450 * MiB;
constexpr size_t WS_KD = 452 * MiB;
constexpr size_t WS_SSMT = 454 * MiB, SSMT_LAYER = 10 * MiB;
constexpr int SSM_NFRAG = 65 + 256 + 256;
constexpr size_t WS_BIAS = 475 * MiB;
constexpr int BIAS_LAYER = NB * PC + NB * 2 * DFF;
constexpr size_t WS_WMODT = 477 * MiB;
constexpr size_t WS_A16 = 501 * MiB;
constexpr size_t WS_SSQ = 504 * MiB;
constexpr size_t WS_END = 506 * MiB;
static_assert(WS_AP + (size_t)NL * 1024 * 65 * 8 <= WS_KD && WS_KD + (size_t)NL * 16 * 64 * 256 * 4 <= WS_SSMT, "ws map");

#define GAS __attribute__((address_space(1)))
#define LAS __attribute__((address_space(3)))
typedef unsigned short bf16_t;
typedef float f32x2v __attribute__((ext_vector_type(2))); typedef float f32x4v __attribute__((ext_vector_type(4))); typedef unsigned u32x2v __attribute__((ext_vector_type(2))); typedef unsigned short u16x4v __attribute__((ext_vector_type(4)));
typedef GAS const float* gcf32; typedef GAS float* gf32; typedef GAS const bf16_t* gcb16; typedef GAS bf16_t* gb16; typedef GAS const unsigned char* gcu8; typedef GAS unsigned char* gu8;
__device__ __forceinline__ float bf2f(bf16_t v) { return __uint_as_float((unsigned)v << 16); }
__device__ __forceinline__ bf16_t f2bf(float f) { unsigned u = __float_as_uint(f); return (bf16_t)((u + 0x7fffu + ((u >> 16) & 1u)) >> 16); }
__device__ __forceinline__ float siluf_(float x) { return x / (1.f + __expf(-x)); }
__device__ __forceinline__ float gelu_tanh(float x) { const float u = 0.7978845608028654f * (x + 0.044715f * x * x * x); return 0.5f * x * (1.f + tanhf(u)); }
__device__ __forceinline__ int refcol_of(int c) {
    if (c < PC_KI) return c;
    if (c < PC_WI) return 1920 + (c - PC_KI);
    if (c < PC_WI + 4) return 1984 + (c - PC_WI);
    if (c < PC_QI) return -1;
    if (c < PC_G) return 1664 + (c - PC_QI);
    return 1988 + (c - PC_G);
}
constexpr int NWAVES = 8, NTHREADS = 512, GRID = 256, NGW = GRID * NWAVES;
constexpr int LDS_BYTES = 147456, MISC_OFF = 145408;
}
__device__ __forceinline__ int lane_id_here() { int l; asm volatile("v_mbcnt_lo_u32_b32 %0, -1, 0\n\tv_mbcnt_hi_u32_b32 %0, -1, %0" : "=v"(l)); return l; }
namespace pg8 {
#define PG8_LAS __attribute__((address_space(3)))
typedef unsigned short bf16_t;
typedef short bf16x8 __attribute__((ext_vector_type(8)));
typedef float f32x4 __attribute__((ext_vector_type(4)));
typedef unsigned u32x4 __attribute__((ext_vector_type(4)));
constexpr int BM = 256, BK = 64, HALF = 128, HTB = HALF * BK * 2  , STAGE_BYTES = 8 * HTB, NXCD = 8, WGM = 8;

__host__ __device__ __forceinline__ int lds_byte(int r, int c) { const int st = (r >> 4) * 2 + (c >> 5), rr = r & 15, cc = c & 31, ob = rr * 64 + cc * 2; return st * 1024 + (ob ^ (((ob >> 9) & 1) << 5)); }
__host__ __device__ __forceinline__ void stage_rc(int b, int& R, int& C) { const int st = b / 1024, sb = b % 1024, swz = sb ^ (((sb >> 9) & 1) << 5); R = (st >> 1) * 16 + swz / 64; C = (st & 1) * 32 + (swz % 64) / 2; }
__host__ __device__ __forceinline__ int perm32(int rho) { const int n = rho >> 4, i = rho & 15; return 8 * (i >> 2) + 4 * n + (i & 3); }

struct Unit { int pm, pn; };
struct Gemm { const bf16_t* A; const bf16_t* Bt; int M, N, K, lda; };

struct StaticOrder {
    int nM, nN, nwg, G, c;
    __host__ __device__ void init(int M, int N, int G_, int c_) { nM = M / BM; nN = N / BM; nwg = nM * nN; G = G_; c = c_; }
    __host__ __device__ bool next(int i, Unit& u) const {
        const long L = (long)i * G + c; if (L >= nwg) return false;
        int wgid = (int)L; { const int q = nwg / NXCD, r = nwg % NXCD, xcd = wgid % NXCD, off = wgid / NXCD; wgid = (xcd < r ? xcd * (q + 1) : r * (q + 1) + (xcd - r) * q) + off; }
        const int nig = WGM * nN, gid = wgid / nig, fm = gid * WGM, gsz = (nM - fm) < WGM ? (nM - fm) : WGM;
        u.pm = fm + ((wgid % nig) % gsz); u.pn = (wgid % nig) / gsz; return true;
    }
    __device__ __forceinline__ void a_ready(const Unit&) const {}
    __device__ __forceinline__ void done(const Unit&) const {}
};

__device__ __forceinline__ unsigned cvt_pk_bf16(float lo, float hi) { unsigned r; asm volatile("v_cvt_pk_bf16_f32 %0, %1, %2" : "=v"(r) : "v"(lo), "v"(hi)); return r; }
template <class Epi, class Sched, bool ALIGN_EPI = false, bool SP2 = false>
__device__ __forceinline__ void gemm_phase(PG8_LAS unsigned char* lds, const Gemm g, const Sched& S, const Epi& E, int wave_s) {
    int ws_ = wave_s; asm volatile("" : "+s"(ws_));
    const int tid = ws_ * 64 + lane_id_here(), wid = ws_,
              lane = tid & 63, wr = wid >> 2, wc = wid & 3, fr = lane & 15, fq = lane >> 4;
    const int K = g.K, nt = K / BK;
    unsigned voffA[2], voffB[2];
#pragma unroll
    for (int i = 0; i < 2; ++i) { int R, C; stage_rc(tid * 16 + i * 8192, R, C); const int Rb = Epi::PERM ? ((R & ~31) + perm32(R & 31)) : R;
        voffA[i] = (unsigned)(R * g.lda + C) * 2u; voffB[i] = (unsigned)(Rb * K + C) * 2u; }
    const size_t kstep = (size_t)(BK * 2);
    const size_t hstepB = (size_t)HALF * K * 2, hstepA = (size_t)HALF * g.lda * 2;
    const size_t tstepB = 2 * hstepB, tstepA = 2 * hstepA;
    const unsigned ldsw = (unsigned)wid * 1024u;
    const int aoff = lds_byte(wr * 64 + fr, fq * 8), boff = lds_byte(wc * 32 + fr, fq * 8);
#define PG8_SA(b, h) (((b) * 2 + (h)) * HTB)
#define PG8_SB(b, h) ((4 + (b) * 2 + (h)) * HTB)
#define PG8_STAGE(bufoff, gbase, voff) do { _Pragma("unroll") for (int _i = 0; _i < 2; ++_i) \
        __builtin_amdgcn_global_load_lds((const unsigned*)((const char*)(gbase) + (voff)[_i]), (PG8_LAS unsigned*)(lds + (bufoff) + ldsw + _i * 8192), 16, 0, 0); } while (0)
#define PG8_LDA(dst, b, h) do { _Pragma("unroll") for (int m = 0; m < 4; ++m) _Pragma("unroll") for (int k = 0; k < 2; ++k) dst[m][k] = *(const PG8_LAS bf16x8*)(lds + PG8_SA(b, h) + aoff + m * 2048 + k * 1024); } while (0)
#define PG8_LDB(dst, b, h) do { _Pragma("unroll") for (int n = 0; n < 2; ++n) _Pragma("unroll") for (int k = 0; k < 2; ++k) dst[n][k] = *(const PG8_LAS bf16x8*)(lds + PG8_SB(b, h) + boff + n * 2048 + k * 1024); } while (0)
#define PG8_MMA(ai, bj, At, Bt) do { __builtin_amdgcn_s_setprio(1); _Pragma("unroll") for (int m = 0; m < 4; ++m) _Pragma("unroll") for (int n = 0; n < 2; ++n) _Pragma("unroll") for (int k = 0; k < 2; ++k) \
        acc[ai][bj][m][n] = __builtin_amdgcn_mfma_f32_16x16x32_bf16(Bt[n][k], At[m][k], acc[ai][bj][m][n], 0, 0, 0); __builtin_amdgcn_s_setprio(0); } while (0)
#define PG8_WAIT_V(n) asm volatile("s_waitcnt vmcnt(" #n ")" ::: "memory")
#define PG8_WAIT_L(n) asm volatile("s_waitcnt lgkmcnt(" #n ")" ::: "memory")
#define PG8_BAR __builtin_amdgcn_s_barrier()
#define PG8_SCHED __builtin_amdgcn_sched_barrier(0)
    Unit cur, nxt; int ui = 0;
    if (!S.next(0, cur)) return;
    f32x4 acc[2][2][4][2];
#pragma unroll
    for (int a = 0; a < 2; ++a)
#pragma unroll
        for (int b = 0; b < 2; ++b)
#pragma unroll
            for (int m = 0; m < 4; ++m)
#pragma unroll
                for (int n = 0; n < 2; ++n) acc[a][b][m][n] = (f32x4){0.f, 0.f, 0.f, 0.f};
    bf16x8 At[4][2], B0[2][2], B1[2][2];
    const char* cA = (const char*)g.A + (size_t)cur.pm * tstepA; const char* cB = (const char*)g.Bt + (size_t)cur.pn * tstepB;
    S.a_ready(cur);
    if constexpr (SP2) {
        PG8_STAGE(PG8_SB(0, 0), cB, voffB); PG8_STAGE(PG8_SB(0, 1), cB + hstepB, voffB); PG8_STAGE(PG8_SA(0, 0), cA, voffA); PG8_STAGE(PG8_SA(0, 1), cA + hstepA, voffA);
        if (wr == 1) PG8_BAR;
        PG8_WAIT_V(2); PG8_BAR;
        PG8_STAGE(PG8_SB(1, 0), cB + kstep, voffB); PG8_STAGE(PG8_SA(1, 0), cA + kstep, voffA); PG8_STAGE(PG8_SB(1, 1), cB + hstepB + kstep, voffB);
        PG8_WAIT_V(6); PG8_BAR;
    } else {
        PG8_STAGE(PG8_SB(0, 0), cB, voffB); PG8_STAGE(PG8_SA(0, 0), cA, voffA); PG8_STAGE(PG8_SB(0, 1), cB + hstepB, voffB); PG8_STAGE(PG8_SA(0, 1), cA + hstepA, voffA);
        if (wr == 1) PG8_BAR;
        PG8_WAIT_V(4); PG8_BAR;
        PG8_STAGE(PG8_SB(1, 0), cB + kstep, voffB); PG8_STAGE(PG8_SA(1, 0), cA + kstep, voffA); PG8_STAGE(PG8_SB(1, 1), cB + hstepB + kstep, voffB);
        PG8_WAIT_V(6); PG8_BAR;
    }
    for (;;) {
        const bool has_next = S.next(ui + 1, nxt);
        const char* nA = has_next ? (const char*)g.A + (size_t)nxt.pm * tstepA : cA; const char* nB = has_next ? (const char*)g.Bt + (size_t)nxt.pn * tstepB : cB;
        for (int t = 0; t < nt; t += 2) {
            const bool last = (t == nt - 2);
            const char* a1 = cA + (size_t)(t + 1) * kstep;
            const char* a2 = last ? nA : cA + (size_t)(t + 2) * kstep; const char* b2 = last ? nB : cB + (size_t)(t + 2) * kstep;
            const char* a3 = a2 + kstep; const char* b3 = b2 + kstep;
            if (last && has_next) S.a_ready(nxt);
            if constexpr (SP2) {
            PG8_LDB(B0, 0, 0); PG8_LDB(B1, 0, 1); PG8_SCHED; PG8_LDA(At, 0, 0); PG8_STAGE(PG8_SA(1, 1), a1 + hstepA, voffA);
            PG8_WAIT_V(8); PG8_WAIT_L(0); PG8_BAR; PG8_MMA(0, 0, At, B0); PG8_MMA(0, 1, At, B1); PG8_BAR; PG8_SCHED;
            PG8_LDA(At, 0, 1); PG8_STAGE(PG8_SB(0, 0), b2, voffB); PG8_STAGE(PG8_SB(0, 1), b2 + hstepB, voffB); PG8_STAGE(PG8_SA(0, 0), a2, voffA);
            PG8_WAIT_V(8); PG8_WAIT_L(0); PG8_BAR; PG8_MMA(1, 0, At, B0); PG8_MMA(1, 1, At, B1); PG8_BAR; PG8_SCHED;
            PG8_LDB(B0, 1, 0); PG8_LDB(B1, 1, 1); PG8_SCHED; PG8_LDA(At, 1, 0); PG8_STAGE(PG8_SA(0, 1), a2 + hstepA, voffA);
            PG8_WAIT_V(8); PG8_WAIT_L(0); PG8_BAR; PG8_MMA(0, 0, At, B0); PG8_MMA(0, 1, At, B1); PG8_BAR; PG8_SCHED;
            PG8_LDA(At, 1, 1); PG8_STAGE(PG8_SB(1, 0), b3, voffB); PG8_STAGE(PG8_SB(1, 1), b3 + hstepB, voffB); PG8_STAGE(PG8_SA(1, 0), a3, voffA);
            PG8_WAIT_V(8); PG8_WAIT_L(0); PG8_BAR; PG8_MMA(1, 0, At, B0); PG8_MMA(1, 1, At, B1); PG8_BAR; PG8_SCHED;
            } else {
            PG8_LDB(B0, 0, 0); PG8_SCHED; PG8_LDA(At, 0, 0); PG8_STAGE(PG8_SA(1, 1), a1 + hstepA, voffA);
            PG8_WAIT_L(8); PG8_BAR; PG8_WAIT_L(0); PG8_MMA(0, 0, At, B0); PG8_BAR; PG8_SCHED;
            PG8_LDB(B1, 0, 1); PG8_STAGE(PG8_SB(0, 0), b2, voffB);
            PG8_BAR; PG8_WAIT_L(0); PG8_MMA(0, 1, At, B1); PG8_BAR;
            PG8_LDA(At, 0, 1); PG8_STAGE(PG8_SA(0, 0), a2, voffA);
            PG8_BAR; PG8_WAIT_L(0); PG8_MMA(1, 0, At, B0); PG8_BAR; PG8_SCHED;
            PG8_STAGE(PG8_SB(0, 1), b2 + hstepB, voffB);
            PG8_WAIT_V(6); PG8_BAR; PG8_MMA(1, 1, At, B1); PG8_BAR;
            PG8_LDB(B0, 1, 0); PG8_SCHED; PG8_LDA(At, 1, 0); PG8_STAGE(PG8_SA(0, 1), a2 + hstepA, voffA);
            PG8_WAIT_L(8); PG8_BAR; PG8_WAIT_L(0); PG8_MMA(0, 0, At, B0); PG8_BAR; PG8_SCHED;
            PG8_LDB(B1, 1, 1); PG8_STAGE(PG8_SB(1, 0), b3, voffB);
            PG8_BAR; PG8_WAIT_L(0); PG8_MMA(0, 1, At, B1); PG8_BAR;
            PG8_LDA(At, 1, 1); PG8_STAGE(PG8_SA(1, 0), a3, voffA);
            PG8_BAR; PG8_WAIT_L(0); PG8_MMA(1, 0, At, B0); PG8_BAR; PG8_SCHED;
            PG8_STAGE(PG8_SB(1, 1), b3 + hstepB, voffB);
            PG8_WAIT_V(6); PG8_BAR; PG8_MMA(1, 1, At, B1); PG8_BAR;
            }
        }
        if constexpr (ALIGN_EPI) { if (wr == 0) PG8_BAR; }
        if constexpr (!Epi::AFTER_DRAIN) { const int el = lane_id_here(); E(acc, cur, wr, wc, el & 15, el >> 4); S.done(cur); }
        if (!has_next) break;
#pragma unroll
        for (int a = 0; a < 2; ++a)
#pragma unroll
            for (int b = 0; b < 2; ++b)
#pragma unroll
                for (int m = 0; m < 4; ++m)
#pragma unroll
                    for (int n = 0; n < 2; ++n) acc[a][b][m][n] = (f32x4){0.f, 0.f, 0.f, 0.f};
        cur = nxt; cA = nA; cB = nB; ++ui;
        if constexpr (ALIGN_EPI) { if (wr == 1) PG8_BAR; }
    }
    PG8_WAIT_V(0);
    if constexpr (!ALIGN_EPI) { if (wr == 0) PG8_BAR; }
    PG8_BAR;
    if constexpr (Epi::AFTER_DRAIN) { E.fused(acc, cur, wr, wc, fr, fq, lds, wid, lane); S.done(cur); }
#undef PG8_SA
#undef PG8_SB
#undef PG8_STAGE
#undef PG8_LDA
#undef PG8_LDB
#undef PG8_MMA
#undef PG8_WAIT_V
#undef PG8_WAIT_L
#undef PG8_BAR
#undef PG8_SCHED
}
}
namespace {
using pg8::f32x4; using pg8::u32x4; using pg8::Unit;
__device__ __forceinline__ float fast_sigmoid(float x) { return __builtin_amdgcn_rcpf(1.f + __expf(-x)); }
__device__ __forceinline__ f32x4 bf4_lo(unsigned a, unsigned b) { return (f32x4){__uint_as_float(a << 16), __uint_as_float(a & 0xffff0000u), __uint_as_float(b << 16), __uint_as_float(b & 0xffff0000u)}; }
__device__ __forceinline__ u32x4 pack8(const f32x4& v0, const f32x4& v1) { u32x4 w; w.x = pg8::cvt_pk_bf16(v0[0], v0[1]); w.y = pg8::cvt_pk_bf16(v0[2], v0[3]); w.z = pg8::cvt_pk_bf16(v1[0], v1[1]); w.w = pg8::cvt_pk_bf16(v1[2], v1[3]); return w; }
typedef GAS const unsigned long long* gcu64; typedef GAS unsigned long long* gu64;
__device__ __forceinline__ float rstd_of(gcu64 ssq, int row) { return rsqrtf((float)ssq[row] * (1.f / (1048576.f * D)) + 1e-6f); }
struct EpiInproj {
    static constexpr bool PERM = true, AFTER_DRAIN = false;
    gb16 P; gcf32 bias; gcu64 ssq;
    __device__ __forceinline__ void operator()(const f32x4 (&acc)[2][2][4][2], const Unit& u, int wr, int wc, int fr, int fq) const {
        const int row0 = u.pm * 256 + wr * 64 + fr, col0 = u.pn * 256 + wc * 32 + 8 * fq; gcf32 bb = bias + (size_t)(u.pm >> 3) * PC + col0;
        f32x4 bv[2][2];
#pragma unroll
        for (int bj = 0; bj < 2; ++bj)
#pragma unroll
            for (int n = 0; n < 2; ++n) bv[bj][n] = *(const GAS f32x4*)(bb + bj * 128 + 4 * n);
        float rsv[2][4];
#pragma unroll
        for (int ai = 0; ai < 2; ++ai)
#pragma unroll
            for (int m = 0; m < 4; ++m) rsv[ai][m] = rstd_of(ssq, row0 + ai * 128 + m * 16);
#pragma unroll
        for (int ai = 0; ai < 2; ++ai)
#pragma unroll
            for (int m = 0; m < 4; ++m) { const int row = row0 + ai * 128 + m * 16; gb16 rowp = P + (size_t)row * PC + col0; const float rs = rsv[ai][m];
#pragma unroll
                for (int bj = 0; bj < 2; ++bj) { const f32x4 v0 = acc[ai][bj][m][0] * rs + bv[bj][0], v1 = acc[ai][bj][m][1] * rs + bv[bj][1];
                    *(GAS u32x4*)(rowp + bj * 128) = pack8(v0, v1); } }
    }
};
struct EpiFfnIn {
    static constexpr bool PERM = true, AFTER_DRAIN = false;
    gb16 ACT; gcf32 bias; gcu64 ssq;
    __device__ __forceinline__ void operator()(const f32x4 (&acc)[2][2][4][2], const Unit& u, int wr, int wc, int fr, int fq) const {
        const int row0 = u.pm * 256 + wr * 64 + fr, col0 = u.pn * 128 + wc * 32 + 8 * fq; gcf32 bb = bias + (size_t)(u.pm >> 3) * 2 * DFF + u.pn * 256 + wc * 32 + 8 * fq;
        f32x4 bv[2][2];
#pragma unroll
        for (int bj = 0; bj < 2; ++bj)
#pragma unroll
            for (int n = 0; n < 2; ++n) bv[bj][n] = *(const GAS f32x4*)(bb + bj * 128 + 4 * n);
        float rsv[2][4];
#pragma unroll
        for (int ai = 0; ai < 2; ++ai)
#pragma unroll
            for (int m = 0; m < 4; ++m) rsv[ai][m] = rstd_of(ssq, row0 + ai * 128 + m * 16);
#pragma unroll
        for (int ai = 0; ai < 2; ++ai)
#pragma unroll
            for (int m = 0; m < 4; ++m) { const int row = row0 + ai * 128 + m * 16; const float rs = rsv[ai][m]; f32x4 o[2];
#pragma unroll
                for (int n = 0; n < 2; ++n) { const f32x4 g = acc[ai][0][m][n] * rs + bv[0][n], up = acc[ai][1][m][n] * rs + bv[1][n];
#pragma unroll
                    for (int e = 0; e < 4; ++e) o[n][e] = g[e] * fast_sigmoid(g[e]) * up[e]; }
                *(GAS u32x4*)(ACT + (size_t)row * DFF + col0) = pack8(o[0], o[1]); }
    }
};
constexpr int RES_CH = 2;
template <int e16> __device__ __forceinline__ float swz16(float v) { return __int_as_float(__builtin_amdgcn_ds_swizzle(__float_as_int(v), (e16 << 10) | 0x1F)); }
struct EpiRes {
    static constexpr bool PERM = true, AFTER_DRAIN = false;
    gcf32 Xin32; gcb16 Xin16; gf32 Xout32; gb16 Xout16;
    gcf32 g;
    gu64 ssq_out; gb16 Hn; gcf32 gain_n; gcf32 sc_n;
    __device__ __forceinline__ void operator()(const f32x4 (&acc)[2][2][4][2], const Unit& u, int wr, int wc, int fr, int fq) const {
        const int row0 = u.pm * 256 + wr * 64 + fr, col0 = u.pn * 256 + wc * 32 + 8 * fq; const size_t boff = (size_t)(u.pm >> 3) * 6 * D + col0;
        f32x4 gv[2][2], gm[2][2];
#pragma unroll
        for (int bj = 0; bj < 2; ++bj)
#pragma unroll
            for (int n = 0; n < 2; ++n) { gv[bj][n] = *(const GAS f32x4*)(g + boff + bj * 128 + 4 * n);
                if (Hn) { const f32x4 ga = *(const GAS f32x4*)(gain_n + col0 + bj * 128 + 4 * n), sc = *(const GAS f32x4*)(sc_n + boff + bj * 128 + 4 * n); gm[bj][n] = ga * (sc + 1.0f); } }
#pragma unroll
        for (int am = 0; am < 8; am += RES_CH) {
            f32x4 xi[RES_CH][2][2];
            if (Xin16) {
                u32x4 xw[RES_CH][2];
#pragma unroll
                for (int mm = 0; mm < RES_CH; ++mm)
#pragma unroll
                    for (int bj = 0; bj < 2; ++bj) xw[mm][bj] = *(const GAS u32x4*)(Xin16 + (size_t)(row0 + ((am + mm) >> 2) * 128 + ((am + mm) & 3) * 16) * D + col0 + bj * 128);
#pragma unroll
                for (int mm = 0; mm < RES_CH; ++mm)
#pragma unroll
                    for (int bj = 0; bj < 2; ++bj) { xi[mm][bj][0] = bf4_lo(xw[mm][bj].x, xw[mm][bj].y); xi[mm][bj][1] = bf4_lo(xw[mm][bj].z, xw[mm][bj].w); }
            } else {
#pragma unroll
                for (int mm = 0; mm < RES_CH; ++mm)
#pragma unroll
                    for (int bj = 0; bj < 2; ++bj)
#pragma unroll
                        for (int n = 0; n < 2; ++n) xi[mm][bj][n] = *(const GAS f32x4*)(Xin32 + (size_t)(row0 + ((am + mm) >> 2) * 128 + ((am + mm) & 3) * 16) * D + col0 + bj * 128 + 4 * n);
            }
#pragma unroll
            for (int mm = 0; mm < RES_CH; ++mm) { const int ai = (am + mm) >> 2, m = (am + mm) & 3, row = row0 + ai * 128 + m * 16; const size_t off = (size_t)row * D + col0; float s = 0.f;
#pragma unroll
                for (int bj = 0; bj < 2; ++bj) { f32x4 xn[2];
#pragma unroll
                    for (int n = 0; n < 2; ++n) { xn[n] = xi[mm][bj][n] + gv[bj][n] * acc[ai][bj][m][n];
                        s += (xn[n][0] * xn[n][0] + xn[n][1] * xn[n][1]) + (xn[n][2] * xn[n][2] + xn[n][3] * xn[n][3]); }
                    if (Xout16) *(GAS u32x4*)(Xout16 + off + bj * 128) = pack8(xn[0], xn[1]);
                    else { *(GAS f32x4*)(Xout32 + off + bj * 128) = xn[0]; *(GAS f32x4*)(Xout32 + off + bj * 128 + 4) = xn[1]; }
                    if (Hn) *(GAS u32x4*)(Hn + off + bj * 128) = pack8(xn[0] * gm[bj][0], xn[1] * gm[bj][1]); }
                s += swz16<16>(s); { auto rr = __builtin_amdgcn_permlane32_swap(__float_as_uint(s), __float_as_uint(s), false, false); s = __uint_as_float(rr[0]) + __uint_as_float(rr[1]); }
                if (fq == 0) atomicAdd((unsigned long long*)(ssq_out + row), (unsigned long long)(s * 1048576.f + 0.5f)); } }
    }
};
struct EpiMod {
    static constexpr bool PERM = false, AFTER_DRAIN = false;
    gf32 mod; gcf32 b_mod; gb16 sh1, sh2;
    __device__ __forceinline__ void operator()(const f32x4 (&acc)[2][2][4][2], const Unit& u, int wr, int wc, int fr, int fq) const {
        if (wr != 0) return;
        const int col0 = u.pn * 256 + wc * 32 + 4 * fq;
#pragma unroll
        for (int bj = 0; bj < 2; ++bj)
#pragma unroll
            for (int n = 0; n < 2; ++n) { const int c = col0 + bj * 128 + n * 16; const f32x4 v = acc[0][bj][0][n] + *(const GAS f32x4*)(b_mod + c);
                *(GAS f32x4*)(mod + (size_t)fr * 6 * D + c) = v;
                gb16 sh = c < D ? sh1 + c : (c >= 3 * D && c < 4 * D) ? sh2 + (c - 3 * D) : (gb16)nullptr;
                if (sh) { u32x2v w; w.x = pg8::cvt_pk_bf16(v[0], v[1]); w.y = pg8::cvt_pk_bf16(v[2], v[3]); *(GAS u32x2v*)(sh + (size_t)fr * D) = w; } }
    }
};
struct EpiBias {
    static constexpr bool PERM = false, AFTER_DRAIN = false;
    gf32 out; int ncols; gcf32 add; int add_from;
    __device__ __forceinline__ void operator()(const f32x4 (&acc)[2][2][4][2], const Unit& u, int wr, int wc, int fr, int fq) const {
        if (wr != 0) return;
        const int col0 = u.pn * 256 + wc * 32 + 4 * fq;
#pragma unroll
        for (int bj = 0; bj < 2; ++bj)
#pragma unroll
            for (int n = 0; n < 2; ++n) { const int c = col0 + bj * 128 + n * 16; f32x4 v = acc[0][bj][0][n];
                if (add && c >= add_from) v = v + *(const GAS f32x4*)(add + (c - add_from));
                *(GAS f32x4*)(out + (size_t)fr * ncols + c) = v; }
    }
};
struct EpiGlu {
    static constexpr bool PERM = true, AFTER_DRAIN = false;
    gb16 P;
    __device__ __forceinline__ void operator()(const f32x4 (&acc)[2][2][4][2], const Unit& u, int wr, int wc, int fr, int fq) const {
        const int row0 = u.pm * 256 + wr * 64 + fr, col0 = u.pn * 128 + wc * 32 + 8 * fq;
#pragma unroll
        for (int ai = 0; ai < 2; ++ai) {
            u32x4 gwv[4];
#pragma unroll
            for (int m = 0; m < 4; ++m) gwv[m] = *(const GAS u32x4*)(P + (size_t)(row0 + ai * 128 + m * 16) * PC + PC_G + D + col0);
#pragma unroll
            for (int m = 0; m < 4; ++m) { gb16 rowp = P + (size_t)(row0 + ai * 128 + m * 16) * PC;
                const u32x4 gw = gwv[m]; f32x4 g0 = bf4_lo(gw.x, gw.y), g1 = bf4_lo(gw.z, gw.w); f32x4 o[2];
#pragma unroll
                for (int e = 0; e < 4; ++e) { g0[e] = fast_sigmoid(g0[e]); g1[e] = fast_sigmoid(g1[e]); }
#pragma unroll
                for (int e = 0; e < 4; ++e) { o[0][e] = g0[e] * acc[ai][0][m][0][e] * fast_sigmoid(acc[ai][1][m][0][e]); o[1][e] = g1[e] * acc[ai][0][m][1][e] * fast_sigmoid(acc[ai][1][m][1][e]); }
                *(GAS u32x4*)(rowp + col0) = pack8(o[0], o[1]); } }
    }
};
struct EpiMixAcc {
    static constexpr bool PERM = true, AFTER_DRAIN = false;
    gb16 P; int gate_off;
    __device__ __forceinline__ void operator()(const f32x4 (&acc)[2][2][4][2], const Unit& u, int wr, int wc, int fr, int fq) const {
        const int row0 = u.pm * 256 + wr * 64 + fr, col0 = u.pn * 256 + wc * 32 + 8 * fq;
#pragma unroll
        for (int am = 0; am < 8; ++am) { const int ai = am >> 2, m0 = am & 3;
            u32x4 gwv[1][2], owv[1][2];
#pragma unroll
            for (int mm = 0; mm < 1; ++mm)
#pragma unroll
                for (int bj = 0; bj < 2; ++bj) { gcb16 rp = P + (size_t)(row0 + ai * 128 + (m0 + mm) * 16) * PC + col0 + bj * 128; gwv[mm][bj] = *(const GAS u32x4*)(rp + gate_off); owv[mm][bj] = *(const GAS u32x4*)rp; }
#pragma unroll
            for (int mm = 0; mm < 1; ++mm) { const int m = m0 + mm; gb16 rowp = P + (size_t)(row0 + ai * 128 + m * 16) * PC;
#pragma unroll
                for (int bj = 0; bj < 2; ++bj) { const int c = col0 + bj * 128;
                    const u32x4 gw = gwv[mm][bj], ow = owv[mm][bj];
                    f32x4 g0 = bf4_lo(gw.x, gw.y), g1 = bf4_lo(gw.z, gw.w);
#pragma unroll
                    for (int e = 0; e < 4; ++e) { g0[e] = fast_sigmoid(g0[e]); g1[e] = fast_sigmoid(g1[e]); }
                    const f32x4 v0 = bf4_lo(ow.x, ow.y) + g0 * acc[ai][bj][m][0], v1 = bf4_lo(ow.z, ow.w) + g1 * acc[ai][bj][m][1];
                    *(GAS u32x4*)(rowp + c) = pack8(v0, v1); } } }
    }
};

#define XB_TMO      128
#define XB_XCNT(j)  (256  + 64 * (j))
#define XB_XSUB(j)  (1280 + 64 * (j))
#define XB_XGEN(j)  (2304 + 64 * (j))
#define XB_TOP      3328
#define XB_TOPGEN   3392
#define XCD_BAR_WORDS 3456
#define XB_SPIN_CAP (1u << 20)
__device__ __forceinline__ unsigned xb_ld(unsigned* p)              { return __hip_atomic_load(p, __ATOMIC_RELAXED, __HIP_MEMORY_SCOPE_AGENT); }
__device__ __forceinline__ unsigned xb_add(unsigned* p, unsigned v) { return __hip_atomic_fetch_add(p, v, __ATOMIC_RELAXED, __HIP_MEMORY_SCOPE_AGENT); }
__device__ __forceinline__ unsigned xb_xcc_id() { return (unsigned)__builtin_amdgcn_s_getreg((3 << 11) | 20) & 0xFu; }
#define XB_SPIN(cond, bar) do { unsigned _sp = 0; while (cond) { __builtin_amdgcn_s_sleep(1); \
    if ((++_sp & 255u) == 0u) { if (xb_ld(&(bar)[XB_TMO])) break; if (_sp > XB_SPIN_CAP) { atomicAdd(&(bar)[XB_TMO], 1u); break; } } } } while (0)
struct XcdBarrier { unsigned* bar; unsigned x; volatile LAS unsigned* st; unsigned total; };
__device__ __forceinline__ XcdBarrier xcd_barrier_post(unsigned* bar, volatile LAS unsigned* st, int wave_s, unsigned total) {
    XcdBarrier b; b.bar = bar; b.x = xb_xcc_id(); b.st = st; b.total = total;
    if (wave_s == 0 && lane_id_here() == 0) (void)xb_add(&bar[XB_XCNT(b.x)], 1u);
    return b;
}
__device__ __forceinline__ void xcd_barrier_complete(unsigned* bar, unsigned x, unsigned G, unsigned& nloc, unsigned& nx) {
    unsigned sum, cnt, mine, sp = 0u;
    for (;;) {
        sum = 0u; cnt = 0u; mine = 0u;
#pragma unroll
        for (unsigned j = 0; j < 16; ++j) { const unsigned c = xb_ld(&bar[XB_XCNT(j)]); sum += c; cnt += (c > 0u) ? 1u : 0u; mine = (j == x) ? c : mine; }
        if (sum == G) break;
        __builtin_amdgcn_s_sleep(1);
        if ((++sp & 255u) == 0u) { if (xb_ld(&bar[XB_TMO])) break; if (sp > XB_SPIN_CAP) { atomicAdd(&bar[XB_TMO], 1u); break; } }
    }
    nloc = mine > 0u ? mine : 1u; nx = cnt > 0u ? cnt : 1u;
}
__device__ __forceinline__ void xcd_barrier(const XcdBarrier& b, int wave_s) {
    asm volatile("s_waitcnt vmcnt(0)" ::: "memory");
    __syncthreads();
    if (wave_s == 0 && lane_id_here() == 0) {
        unsigned* bar = b.bar; unsigned bx = b.x; asm volatile("" : "+s"(bar), "+s"(bx));
        __builtin_amdgcn_s_waitcnt(0);
        unsigned nloc = b.st[0], nx = b.st[1];
        if (nloc == 0u) { xcd_barrier_complete(bar, bx, b.total, nloc, nx); b.st[0] = nloc; b.st[1] = nx; }
        const unsigned old = xb_add(&bar[XB_XSUB(bx)], 1u);
        const unsigned gen = old / nloc;
        if (old + 1u == (gen + 1u) * nloc) {
            __builtin_amdgcn_fence(__ATOMIC_RELEASE, "agent");
            asm volatile("s_waitcnt vmcnt(0)" ::: "memory");
            const unsigned og = xb_add(&bar[XB_TOP], 1u);
            const unsigned tg = og / nx;
            if (og + 1u == (tg + 1u) * nx) xb_add(&bar[XB_TOPGEN], 1u);
            else XB_SPIN(xb_ld(&bar[XB_TOPGEN]) == tg, bar);
            __builtin_amdgcn_fence(__ATOMIC_ACQUIRE, "agent");
            xb_add(&bar[XB_XGEN(bx)], 1u);
            asm volatile("s_waitcnt vmcnt(0)" ::: "memory");
        } else {
            XB_SPIN(xb_ld(&bar[XB_XGEN(bx)]) == gen, bar);
            __builtin_amdgcn_fence(__ATOMIC_ACQUIRE, "agent");
            asm volatile("s_waitcnt vmcnt(0)" ::: "memory");
        }
    }
    __syncthreads();
}


struct Args { const float* in[24]; float* out; unsigned char* ws; };

template <int K> __device__ __forceinline__ float swz_xor(float v) { return __int_as_float(__builtin_amdgcn_ds_swizzle(__float_as_int(v), (K << 10) | 0x1F)); }
__device__ __forceinline__ float wave_sum(float v) { v += swz_xor<1>(v); v += swz_xor<2>(v); v += swz_xor<4>(v); v += swz_xor<8>(v); v += swz_xor<16>(v);
    auto rr = __builtin_amdgcn_permlane32_swap(__float_as_uint(v), __float_as_uint(v), false, false); return __uint_as_float(rr[0]) + __uint_as_float(rr[1]); }
__device__ __forceinline__ unsigned sortable(float f) { const unsigned b = __float_as_uint(f); return (b & 0x80000000u) ? ~b : (b | 0x80000000u); }
__device__ __forceinline__ float unsortable(unsigned u) { return __uint_as_float((u & 0x80000000u) ? (u ^ 0x80000000u) : ~u); }

__device__ __forceinline__ void ph_a16(gcf32 c, gb16 A16, gu64 ssq, int gw, int lane) {
    for (int it = gw * 64 + lane; it < 4 * M; it += NGW * 64) ssq[M + it] = 0ull;
    for (int it = gw * 64 + lane; it < 5 * 256 * D / 8; it += NGW * 64) { const int e = it * 8, mtx = e / (256 * D), r = (e / D) & 255, k = e & (D - 1);
        u32x4 w = {0u, 0u, 0u, 0u};
        if (mtx == 0 && r < 16) { gcf32 cp = c + r * D + k; w.x = pg8::cvt_pk_bf16(siluf_(cp[0]), siluf_(cp[1])); w.y = pg8::cvt_pk_bf16(siluf_(cp[2]), siluf_(cp[3])); w.z = pg8::cvt_pk_bf16(siluf_(cp[4]), siluf_(cp[5])); w.w = pg8::cvt_pk_bf16(siluf_(cp[6]), siluf_(cp[7])); }
        if (mtx == 0 || r >= 16) *(GAS u32x4*)(A16 + e) = w; }
}
__device__ __forceinline__ void ph_h0(gcf32 x, gcf32 gain, gcf32 modl, int sc_off, gb16 H, gu64 ssq, int gw, int ngw, int lane) {
    for (int t0 = 4 * gw; t0 < M; t0 += 4 * ngw) {
        const int b = t0 / S; f32x4v v[4][4]; float s[4];
#pragma unroll
        for (int q = 0; q < 4; ++q) { const GAS f32x4v* xr = (const GAS f32x4v*)(x + (size_t)(t0 + q) * D) + lane;
#pragma unroll
            for (int j = 0; j < 4; ++j) v[q][j] = xr[64 * j]; }
        gcf32 mb = modl + (size_t)b * 6 * D; f32x4v gm[4];
#pragma unroll
        for (int j = 0; j < 4; ++j) { const int k = 4 * lane + 256 * j; const f32x4v g = *(const GAS f32x4v*)(gain + k), sc = *(const GAS f32x4v*)(mb + sc_off + k); gm[j] = g * (sc + 1.0f); }
#pragma unroll
        for (int q = 0; q < 4; ++q) { float a = 0.f;
#pragma unroll
            for (int j = 0; j < 4; ++j) a += v[q][j].x * v[q][j].x + v[q][j].y * v[q][j].y + v[q][j].z * v[q][j].z + v[q][j].w * v[q][j].w;
            s[q] = wave_sum(a); }
        if (lane < 4) ssq[t0 + lane] = (unsigned long long)((lane == 0 ? s[0] : lane == 1 ? s[1] : lane == 2 ? s[2] : s[3]) * 1048576.f + 0.5f);
#pragma unroll
        for (int q = 0; q < 4; ++q)
#pragma unroll
            for (int j = 0; j < 4; ++j) { const int k = 4 * lane + 256 * j; const f32x4v o = v[q][j] * gm[j];
                u32x2v w; w.x = pg8::cvt_pk_bf16(o.x, o.y); w.y = pg8::cvt_pk_bf16(o.z, o.w); *(GAS u32x2v*)(H + (size_t)(t0 + q) * D + k) = w; }
    }
}
__device__ __forceinline__ void ph_final_norm(gcf32 x, gf32 out, gcf32 gain, gcu64 ssq, int tok0, int ntok, int gw, int ngw, int lane) {
    f32x4v g[4];
#pragma unroll
    for (int j = 0; j < 4; ++j) g[j] = *(const GAS f32x4v*)(gain + 4 * lane + 256 * j);
    for (int t0 = tok0 + 4 * gw; t0 < tok0 + ntok; t0 += 4 * ngw) {
        f32x4v v[4][4]; float rs[4];
#pragma unroll
        for (int q = 0; q < 4; ++q) { const GAS f32x4v* xr = (const GAS f32x4v*)(x + (size_t)(t0 + q) * D) + lane; rs[q] = rstd_of(ssq, t0 + q);
#pragma unroll
            for (int j = 0; j < 4; ++j) v[q][j] = xr[64 * j]; }
#pragma unroll
        for (int q = 0; q < 4; ++q) { GAS f32x4v* xr = (GAS f32x4v*)(out + (size_t)(t0 + q) * D) + lane;
#pragma unroll
            for (int j = 0; j < 4; ++j) xr[64 * j] = v[q][j] * g[j] * rs[q]; }
    }
}
__device__ __forceinline__ f32x4 ld_bf4(gcb16 p) { const u32x2v w = *(const GAS u32x2v*)p; return bf4_lo(w.x, w.y); }
__device__ __forceinline__ void ph_conv(gcb16 P, gcf32 conv_w, gb16 CONVA, int gw, int lane) {
    const int j0 = 4 * lane;
    const f32x4 w0 = *(const GAS f32x4*)(conv_w + j0), w1 = *(const GAS f32x4*)(conv_w + 256 + j0), w2 = *(const GAS f32x4*)(conv_w + 512 + j0);
    for (int run = gw; run < M / 16; run += NGW) {
        const int t0 = 16 * run; f32x4 z1 = {0.f, 0.f, 0.f, 0.f}, z2 = {0.f, 0.f, 0.f, 0.f};
        if ((t0 & (S - 1)) != 0) { gcb16 p1 = P + (size_t)(t0 - 1) * PC + j0, p2 = P + (size_t)(t0 - 2) * PC + j0; z1 = ld_bf4(p1 + 256) * ld_bf4(p1 + 512); z2 = ld_bf4(p2 + 256) * ld_bf4(p2 + 512); }
#pragma unroll 4
        for (int i = 0; i < 16; ++i) { gcb16 p = P + (size_t)(t0 + i) * PC + j0;
            const f32x4 z0 = ld_bf4(p + 256) * ld_bf4(p + 512), y = ld_bf4(p) * (w0 * z2 + w1 * z1 + w2 * z0);
            u32x2v o; o.x = pg8::cvt_pk_bf16(y[0], y[1]); o.y = pg8::cvt_pk_bf16(y[2], y[3]); *(GAS u32x2v*)(CONVA + (size_t)(t0 + i) * 256 + j0) = o;
            z2 = z1; z1 = z0; }
    }
}

typedef short bf16x8_t __attribute__((ext_vector_type(8)));
typedef float f32x16_t __attribute__((ext_vector_type(16)));
#define MFMA32(a, b, c) __builtin_amdgcn_mfma_f32_32x32x16_bf16((a), (b), (c), 0, 0, 0)
__device__ __forceinline__ int crow16(int r, int h) { return (r & 3) + 8 * (r >> 2) + 4 * h; }
__device__ __forceinline__ void ph_ssm_params(gcf32 a_re, gcf32 a_im, gcf32 log_dt, gcf32 b_re, gcf32 b_im, gf32 SSMP, gf32 AP, int gw, int lane) {
    for (int it = gw * 64 + lane; it < NL * 1024; it += NGW * 64) {
        const int l = it >> 10, gp = it & 1023, g = gp >> 6;
        const double dt = exp((double)log_dt[l * 16 + g]), ar = a_re[l * 1024 + gp], ai = a_im[l * 1024 + gp];
        const double mag = exp(dt * ar), abr = mag * cos(dt * ai), abi = mag * sin(dt * ai);
        const double den = ar * ar + ai * ai, nr = abr - 1.0, ni = abi;
        const double cr = (nr * ar + ni * ai) / den, ci = (ni * ar - nr * ai) / den;
        gf32 o = SSMP + (size_t)l * SSMP_LAYER;
        o[gp * 2] = (float)abr; o[gp * 2 + 1] = (float)abi;
        for (int j = 0; j < 16; ++j) { const double br = b_re[(l * 1024 + gp) * 16 + j], bi = b_im[(l * 1024 + gp) * 16 + j];
            o[2048 + (gp * 16 + j) * 2] = (float)(cr * br - ci * bi); o[2048 + (gp * 16 + j) * 2 + 1] = (float)(cr * bi + ci * br); }
    }
    for (int it = gw * 64 + lane; it < NL * 1024 * 65; it += NGW * 64) {
        const int d = it % 65, lgp = it / 65, l = lgp >> 10, gp = lgp & 1023, g = gp >> 6;
        const double dt = exp((double)log_dt[l * 16 + g]), ar = a_re[l * 1024 + gp], ai = a_im[l * 1024 + gp];
        const double m2 = exp((double)d * dt * ar), ang = (double)d * dt * ai;
        AP[(size_t)it * 2] = (float)(m2 * cos(ang)); AP[(size_t)it * 2 + 1] = (float)(m2 * sin(ang));
    }
}
__device__ __forceinline__ void ph_ssm_kd(gcf32 a_re, gcf32 a_im, gcf32 log_dt, gcf32 b_re, gcf32 b_im, gcf32 c_re, gcf32 c_im, gf32 KD, LAS float* scr, int gw, int lane) {
    for (int it = gw; it < NL * 16 * 64; it += NGW) {
        const int d = it & 63, lg = it >> 6;
        { const int gp = lg * 64 + lane; const double dt = exp((double)log_dt[lg]), ar = a_re[gp], ai = a_im[gp];
          const double mag = exp(dt * ar), abr = mag * cos(dt * ai), abi = mag * sin(dt * ai), den = ar * ar + ai * ai, nr = abr - 1.0, ni = abi;
          const double cr = (nr * ar + ni * ai) / den, ci = (ni * ar - nr * ai) / den, md = exp((double)d * dt * ar), ang = (double)d * dt * ai, pr = md * cos(ang), pi = md * sin(ang);
          asm volatile("s_waitcnt lgkmcnt(0)" ::: "memory");
          scr[2 * lane] = (float)(pr * cr - pi * ci); scr[2 * lane + 1] = (float)(pr * ci + pi * cr); }
        asm volatile("s_waitcnt lgkmcnt(0)" ::: "memory");
        const int jp = lane & 15, jq = lane >> 4; float acc[4] = {0.f, 0.f, 0.f, 0.f};
        gcf32 br = b_re + (size_t)lg * 1024 + jp, bi = b_im + (size_t)lg * 1024 + jp, cr_ = c_re + (size_t)lg * 1024 + jq * 64, ci_ = c_im + (size_t)lg * 1024 + jq * 64;
#pragma unroll 4
        for (int p = 0; p < 64; ++p) { const float er = scr[2 * p], ei = scr[2 * p + 1], b0 = br[p * 16], b1 = bi[p * 16]; const float zr = er * b0 - ei * b1, zi = er * b1 + ei * b0;
#pragma unroll
            for (int i = 0; i < 4; ++i) acc[i] += cr_[i * 256 + p] * zr - ci_[i * 256 + p] * zi; }
#pragma unroll
        for (int i = 0; i < 4; ++i) KD[((size_t)lg * 64 + d) * 256 + (jq + 4 * i) * 16 + jp] = acc[i];
    }
}
__device__ __forceinline__ void ph_ssm_frags(gcf32 c_re, gcf32 c_im, gcf32 SSMP, gcf32 AP, gcf32 KD, gu8 T, int gw, int lane) {
    const int n = lane & 31, h = lane >> 5;
    for (int f = gw; f < NL * 16 * SSM_NFRAG; f += NGW) {
        const int l = f / (16 * SSM_NFRAG), g = (f / SSM_NFRAG) & 15, k = f % SSM_NFRAG;
        gcf32 ap = AP + (size_t)((l * 16 + g) * 64) * 65 * 2;
        gcf32 bb = SSMP + (size_t)l * SSMP_LAYER + 2048 + (size_t)(g * 64) * 32;
        gcf32 cr = c_re + (size_t)((l * 16 + g) * 16) * 64; gcf32 ci = c_im + (size_t)((l * 16 + g) * 16) * 64;
        float v[8];
        if (k < 65) {
            const int tt = n >> 4, j = n & 15, d = k - 1 + tt;
            if (d >= 0) { gcf32 kd = KD + ((size_t)((l * 16 + g) * 64 + d)) * 256 + j * 16 + 8 * h; const f32x4 k0 = *(const GAS f32x4*)kd, k1 = *(const GAS f32x4*)(kd + 4);
                v[0] = k0[0]; v[1] = k0[1]; v[2] = k0[2]; v[3] = k0[3]; v[4] = k1[0]; v[5] = k1[1]; v[6] = k1[2]; v[7] = k1[3]; }
            else {
#pragma unroll
                for (int e = 0; e < 8; ++e) v[e] = 0.f; }
        } else if (k < 65 + 256) {
            const int kk = k - 65, nb = kk >> 6, s = kk & 63, ng = 32 * nb + n, ri = ng >> 6, p = ng & 63;
            const float adr = ap[(p * 65 + 63 - s) * 2], adi = ap[(p * 65 + 63 - s) * 2 + 1];
#pragma unroll
            for (int e = 0; e < 8; ++e) { const float br = bb[(p * 16 + 8 * h + e) * 2], bi = bb[(p * 16 + 8 * h + e) * 2 + 1]; v[e] = ri == 0 ? adr * br - adi * bi : adr * bi + adi * br; }
        } else {
            const int kk = k - 321, nb = kk >> 3, ks = kk & 7, t = 2 * nb + (n >> 4), j = n & 15;
#pragma unroll
            for (int e = 0; e < 8; ++e) { const int kg = 16 * ks + 8 * h + e, ri = kg >> 6, p = kg & 63;
                const float adr = ap[(p * 65 + t + 1) * 2], adi = ap[(p * 65 + t + 1) * 2 + 1], cjr = cr[j * 64 + p], cji = ci[j * 64 + p];
                v[e] = ri == 0 ? cjr * adr - cji * adi : -(cjr * adi + cji * adr); }
        }
        u32x4 o; o.x = pg8::cvt_pk_bf16(v[0], v[1]); o.y = pg8::cvt_pk_bf16(v[2], v[3]); o.z = pg8::cvt_pk_bf16(v[4], v[5]); o.w = pg8::cvt_pk_bf16(v[6], v[7]);
        *(GAS u32x4*)(T + (size_t)l * SSMT_LAYER + ((size_t)(g * SSM_NFRAG + k) * 64 + lane) * 16) = o;
    }
}
constexpr int SSM_UROW = 2064, SSM_HROW = 272, SSM_SL_OFF = 32 * SSM_UROW, SSM_HP_OFF = SSM_SL_OFF + 16384, SSM_LDS = SSM_HP_OFF + 32 * SSM_HROW;
__device__ __forceinline__ void ssm_fast_item(LAS unsigned char* lds, gcb16 P, gcu8 T  , gcf32 AP  , gcf32 d_skip, gb16 Z, int b, int g, int wave_s) {
    const int lane = lane_id_here(), tid = wave_s * 64 + lane, n = lane & 31, h = lane >> 5;
    gcu8 Tg = T + (size_t)g * SSM_NFRAG * 1024;
#pragma unroll
    for (int i = 0; i < 4; ++i) { const int tok = tid + 512 * i; const GAS u32x4* src = (const GAS u32x4*)(P + (size_t)(b * S + tok) * PC + PC_SSM + g * 16);
        const u32x4 v0 = src[0], v1 = src[1]; LAS u32x4* dst = (LAS u32x4*)(lds + (tok >> 6) * SSM_UROW + (tok & 63) * 32); dst[0] = v0; dst[1] = v1; }
    __syncthreads();
    {
        int ws2 = wave_s; asm volatile("" : "+s"(ws2));
        const int nb = ws2 & 3, kh = ws2 >> 2; f32x16_t acc;
#pragma unroll
        for (int r = 0; r < 16; ++r) acc[r] = 0.f;
        {
            gcu8 bp = Tg + ((size_t)(65 + nb * 64 + 32 * kh) * 64 + lane) * 16; const LAS unsigned char* ap = lds + n * SSM_UROW + (32 * kh) * 32 + 16 * h;
            bf16x8_t cur[8], nxt[8];
#pragma unroll
            for (int i = 0; i < 8; ++i) cur[i] = *(const GAS bf16x8_t*)(bp + i * 1024);
#pragma unroll
            for (int bt = 0; bt < 4; ++bt) {
                if (bt < 3) {
#pragma unroll
                    for (int i = 0; i < 8; ++i) nxt[i] = *(const GAS bf16x8_t*)(bp + (bt * 8 + 8 + i) * 1024); }
#pragma unroll
                for (int i = 0; i < 8; ++i) { const bf16x8_t a = *(const LAS bf16x8_t*)(ap + (bt * 8 + i) * 32); acc = MFMA32(a, cur[i], acc); }
#pragma unroll
                for (int i = 0; i < 8; ++i) cur[i] = nxt[i];
            }
        }
        LAS float* SL = (LAS float*)(lds + SSM_SL_OFF);
        if (kh == 0) {
#pragma unroll
            for (int r = 0; r < 16; ++r) SL[crow16(r, h) * 128 + 32 * nb + n] = acc[r]; }
        __syncthreads();
        if (kh == 1) {
#pragma unroll
            for (int r = 0; r < 16; ++r) SL[crow16(r, h) * 128 + 32 * nb + n] += acc[r]; }
        __syncthreads();
        if (wave_s == 0) {
            const float ar = AP[(size_t)((g * 64 + lane) * 65 + 64) * 2], ai = AP[(size_t)((g * 64 + lane) * 65 + 64) * 2 + 1];
            float hr = 0.f, hi = 0.f;
            for (int c = 0; c < 32; ++c) {
                LAS bf16_t* hp = (LAS bf16_t*)(lds + SSM_HP_OFF + c * SSM_HROW); hp[lane] = f2bf(hr); hp[64 + lane] = f2bf(hi);
                const float sr = SL[c * 128 + lane], si = SL[c * 128 + 64 + lane];
                const float nr = ar * hr - ai * hi + sr, ni = ar * hi + ai * hr + si; hr = nr; hi = ni;
            }
        }
        __syncthreads();
    }
    for (int q = 0; q < 4; ++q) {
        const int nb = (q == 0) ? wave_s : (q == 1) ? 15 - wave_s : (q == 2) ? 16 + wave_s : 31 - wave_s;
        f32x16_t acc;
#pragma unroll
        for (int r = 0; r < 16; ++r) acc[r] = 0.f;
        const int ns = 2 * nb + 2, total = ns + 8;
        {
            gcu8 tp = Tg + ((size_t)(2 * nb + 1) * 64 + lane) * 16, cp = Tg + ((size_t)(321 + nb * 8) * 64 + lane) * 16;
            const LAS unsigned char* ua = lds + n * SSM_UROW + 16 * h; const LAS unsigned char* ha = lds + SSM_HP_OFF + n * SSM_HROW + 16 * h;
#define SSM_BLOAD(dst, k) do { const int k_ = (k); if (k_ < total) dst = *(const GAS bf16x8_t*)(k_ < ns ? tp - (size_t)k_ * 1024 : cp + (size_t)(k_ - ns) * 1024); } while (0)
            bf16x8_t cur[8], nxt[8];
#pragma unroll
            for (int i = 0; i < 8; ++i) SSM_BLOAD(cur[i], i);
            for (int base = 0; base < total; base += 8) {
#pragma unroll
                for (int i = 0; i < 8; ++i) SSM_BLOAD(nxt[i], base + 8 + i);
#pragma unroll
                for (int i = 0; i < 8; ++i) { const int k = base + i;
                    if (k < total) { const bf16x8_t a = *(const LAS bf16x8_t*)(k < ns ? ua + k * 32 : ha + (k - ns) * 32); acc = MFMA32(a, cur[i], acc); } }
#pragma unroll
                for (int i = 0; i < 8; ++i) cur[i] = nxt[i];
            }
#undef SSM_BLOAD
        }
        const int t = 2 * nb + (n >> 4), j = n & 15; const float dsk = d_skip[g * 16 + j];
#pragma unroll
        for (int r = 0; r < 16; ++r) { const int c = crow16(r, h);
            const float u = bf2f(*(const LAS bf16_t*)(lds + c * SSM_UROW + (t * 16 + j) * 2));
            Z[(size_t)(b * S + c * 64 + t) * 256 + g * 16 + j] = f2bf(gelu_tanh(acc[r] + dsk * u)); }
    }
    __syncthreads();
}

typedef short s16x4_t __attribute__((ext_vector_type(4)));
typedef float f32x2_t __attribute__((ext_vector_type(2))); typedef __bf16 bf16x2_t __attribute__((ext_vector_type(2)));
__device__ __forceinline__ unsigned cvtpk(float lo, float hi) { f32x2_t v = {lo, hi}; bf16x2_t b = __builtin_convertvector(v, bf16x2_t); return __builtin_bit_cast(unsigned, b); }
__device__ __forceinline__ int swap32_add(int v) { auto rr = __builtin_amdgcn_permlane32_swap((unsigned)v, (unsigned)v, false, false); return (int)(rr[0] + rr[1]); }
__device__ __forceinline__ unsigned swap32_or(unsigned v) { auto rr = __builtin_amdgcn_permlane32_swap(v, v, false, false); return rr[0] | rr[1]; }
__device__ __forceinline__ float swap32_max(float v) { auto rr = __builtin_amdgcn_permlane32_swap(__float_as_uint(v), __float_as_uint(v), false, false); return fmaxf(__uint_as_float(rr[0]), __uint_as_float(rr[1])); }
__device__ __forceinline__ float swap32_addf(float v) { auto rr = __builtin_amdgcn_permlane32_swap(__float_as_uint(v), __float_as_uint(v), false, false); return __uint_as_float(rr[0]) + __uint_as_float(rr[1]); }
__device__ __forceinline__ int wave_sum_dpp(int v) {
    v += __builtin_amdgcn_update_dpp(0, v, 0x111, 0xf, 0xf, false);
    v += __builtin_amdgcn_update_dpp(0, v, 0x112, 0xf, 0xf, false);
    v += __builtin_amdgcn_update_dpp(0, v, 0x114, 0xf, 0xf, false);
    v += __builtin_amdgcn_update_dpp(0, v, 0x118, 0xf, 0xf, false);
    v += __builtin_amdgcn_update_dpp(0, v, 0x142, 0xa, 0xf, false);
    v += __builtin_amdgcn_update_dpp(0, v, 0x143, 0xc, 0xf, false);
    return __builtin_amdgcn_readlane(v, 63);
}
template <int K> __device__ __forceinline__ unsigned swz_xor_u(unsigned v) { return (unsigned)__builtin_amdgcn_ds_swizzle((int)v, (K << 10) | 0x1F); }
__device__ __forceinline__ unsigned wave_min_u(unsigned v) { v = min(v, swz_xor_u<1>(v)); v = min(v, swz_xor_u<2>(v)); v = min(v, swz_xor_u<4>(v)); v = min(v, swz_xor_u<8>(v)); v = min(v, swz_xor_u<16>(v));
    auto rr = __builtin_amdgcn_permlane32_swap(v, v, false, false); return (unsigned)__builtin_amdgcn_readfirstlane((int)min(rr[0], rr[1])); }
__device__ __forceinline__ unsigned wave_max_u(unsigned v) { v = max(v, swz_xor_u<1>(v)); v = max(v, swz_xor_u<2>(v)); v = max(v, swz_xor_u<4>(v)); v = max(v, swz_xor_u<8>(v)); v = max(v, swz_xor_u<16>(v));
    auto rr = __builtin_amdgcn_permlane32_swap(v, v, false, false); return (unsigned)__builtin_amdgcn_readfirstlane((int)max(rr[0], rr[1])); }
__device__ __forceinline__ s16x4_t tr_read(const LAS unsigned char* p) { typedef short v4i16_t __attribute__((ext_vector_type(4))); return __builtin_bit_cast(s16x4_t, __builtin_amdgcn_ds_read_tr16_b64_v4i16((LAS v4i16_t*)p)); }
constexpr int AT_QIROW = 528, AT_KROW = 144, AT_VROW = 192, AT_GTM = 0, AT_KT = AT_GTM + 16384, AT_VT = AT_KT + 2 * 64 * AT_KROW, AT_QL = AT_VT + 2 * 64 * AT_VROW,
              AT_LDS = AT_QL + 512 * AT_KROW,
              AT_QI = 16384, AT_WI = AT_QI + 64 * AT_QIROW, AT_RD = AT_WI + 1024, AT_RDROW = 521, AT_P1END = AT_RD + 32 * AT_RDROW * 4;
static_assert(AT_LDS <= 143360 && AT_P1END <= 143360, "attention LDS");
static_assert(AT_LDS <= 143360, "attention LDS");
#define AT_BAR() do { asm volatile("s_waitcnt lgkmcnt(0)" ::: "memory"); __builtin_amdgcn_s_barrier(); asm volatile("" ::: "memory"); } while (0)
__device__ __forceinline__ void attn_unit(LAS unsigned char* lds, gcb16 P, gb16 AO, int b, int c, int wave_s) {
    gcb16 Pb = P + (size_t)b * S * PC;
    const int nkb = 2 * (c + 1);
    LAS unsigned* GTM = (LAS unsigned*)(lds + AT_GTM); LAS unsigned* RD = (LAS unsigned*)(lds + AT_RD); LAS float* WI = (LAS float*)(lds + AT_WI);
    AT_BAR();
    {
    const int lane = lane_id_here(), tid = wave_s * 64 + lane, n = lane & 31, h = lane >> 5;
    if (c < 4) {
        for (int e = tid; e < 64 * 64; e += 512) GTM[e] = 0xffffffffu;
    } else {
        { const int row = tid >> 3, pc = tid & 7; const GAS u32x4* src = (const GAS u32x4*)(Pb + (size_t)(c * 64 + row) * PC + PC_QI + pc * 32);
#pragma unroll
          for (int i = 0; i < 4; ++i) *(LAS u32x4*)(lds + AT_QI + row * AT_QIROW + pc * 64 + i * 16) = src[i];
          if (tid < 256) WI[tid] = bf2f(Pb[(size_t)(c * 64 + (tid >> 2)) * PC + PC_WI + (tid & 3)]); }
        AT_BAR();
        for (int rd = 0; rd < 2; ++rd) {
            const int qt = 32 * rd + n; int hq = 4 * h; asm volatile("" : "+v"(hq));
            unsigned sc[8][16];
            bf16x8_t kfn[4]; gcb16 kpn = Pb + (size_t)(wave_s * 32 + n) * PC + PC_KI + 8 * h;
            if (wave_s < nkb) {
#pragma unroll
                for (int s = 0; s < 4; ++s) kfn[s] = *(const GAS bf16x8_t*)(kpn + 16 * s); }
#pragma unroll
            for (int kbi = 0; kbi < 8; ++kbi) {
                const int kb = wave_s + 8 * kbi;
                if (kb < nkb) {
                    bf16x8_t kf[4];
#pragma unroll
                    for (int s = 0; s < 4; ++s) kf[s] = kfn[s];
                    kpn += (size_t)256 * PC; asm volatile("" : "+v"(kpn));
                    if (kb + 8 < nkb) {
#pragma unroll
                        for (int s = 0; s < 4; ++s) kfn[s] = *(const GAS bf16x8_t*)(kpn + 16 * s); }
                    float score[16];
#pragma unroll
                    for (int r = 0; r < 16; ++r) score[r] = 0.f;
#pragma unroll
                    for (int hh = 0; hh < 4; ++hh) { f32x16_t acc;
#pragma unroll
                        for (int r = 0; r < 16; ++r) acc[r] = 0.f;
#pragma unroll
                        for (int s = 0; s < 4; ++s) { const bf16x8_t qf = *(const LAS bf16x8_t*)(lds + AT_QI + qt * AT_QIROW + (hh * 64 + 16 * s + 8 * h) * 2); acc = MFMA32(kf[s], qf, acc); }
                        const float wv = WI[qt * 4 + hh];
#pragma unroll
                        for (int r = 0; r < 16; ++r) score[r] += wv * fmaxf(acc[r], 0.f); }
#pragma unroll
                    for (int r = 0; r < 16; ++r) sc[kbi][r] = (sortable(score[r]) & 0xfffff800u) | (unsigned)((2047 - kb * 32 - ((r & 3) + 8 * (r >> 2))) - hq);
                } else {
#pragma unroll
                    for (int r = 0; r < 16; ++r) sc[kbi][r] = 0u;
                }
            }
            const int nv = nkb >> 1;
            unsigned kv[4][32];
#pragma unroll
            for (int p = 0; p < 4; ++p) {
                AT_BAR();
#pragma unroll
                for (int q2 = 0; q2 < 2; ++q2) { const int kbi = 2 * p + q2, kb = wave_s + 8 * kbi;
                    if (kb < nkb) {
#pragma unroll
                        for (int r = 0; r < 16; ++r) RD[n * AT_RDROW + (wave_s + 8 * q2) * 32 + (r & 3) + 8 * (r >> 2) + 4 * h] = sc[kbi][r]; } }
                AT_BAR();
#pragma unroll
                for (int j = 0; j < 4; ++j)
#pragma unroll
                    for (int i2 = 0; i2 < 8; ++i2) kv[j][8 * p + i2] = (8 * p + i2 < nv) ? RD[(8 * j + wave_s) * AT_RDROW + lane + 64 * i2] : 0u;
            }
#pragma unroll
            for (int j = 0; j < 4; ++j) {
                unsigned mn = 0xffffffffu, mx = 0u;
#pragma unroll
                for (int i = 0; i < 32; ++i) if (i < nv) { mn = min(mn, kv[j][i]); mx = max(mx, kv[j][i]); }
                unsigned lo_u = wave_min_u(mn), hi_u = wave_max_u(mx); hi_u = hi_u == 0xffffffffu ? hi_u : hi_u + 1u;
                int c_lo = 32 * nkb, c_hi = 0;
                for (int iter = 0; iter < 400 && c_lo != 256 && hi_u - lo_u > 1u; ++iter) {
                    unsigned cand;
                    const float fl = unsortable(lo_u), fh = unsortable(hi_u);
                    const bool plateau = lo_u >= 0x80000000u && hi_u <= 0x80000800u;
                    if (iter == 0 && lo_u < 0x80000800u && hi_u > 0x80000800u) cand = 0x80000800u;
                    else if (iter == 1 && lo_u < 0x80000000u && hi_u > 0x80000000u && hi_u <= 0x80000800u) cand = 0x80000000u;
                    else if (plateau || (iter & 7) == 7 || (iter > 24 && (iter & 1))) cand = lo_u + ((hi_u - lo_u) >> 1);
                    else if (iter < 5 || (iter & 1)) cand = sortable(0.5f * fl + 0.5f * fh);
                    else cand = sortable(fl + (fh - fl) * (((float)(c_lo - 256) + 0.5f) * __builtin_amdgcn_rcpf((float)(c_lo - c_hi))));
                    cand = max(cand, lo_u + 1u); cand = min(cand, hi_u - 1u);
                    cand = (unsigned)__builtin_amdgcn_readfirstlane((int)cand);
                    unsigned ca = 0u, cb = 0u;
#pragma unroll
                    for (int i = 0; i < 32; i += 8) if (i < nv) {
                        unsigned long long m0, m1, m2, m3, m4, m5, m6, m7;
                        asm volatile("v_cmp_ge_u32_e64 %2, %10, %18\n\tv_cmp_ge_u32_e64 %3, %11, %18\n\tv_cmp_ge_u32_e64 %4, %12, %18\n\tv_cmp_ge_u32_e64 %5, %13, %18\n\t"
                                     "v_cmp_ge_u32_e64 %6, %14, %18\n\tv_cmp_ge_u32_e64 %7, %15, %18\n\tv_cmp_ge_u32_e64 %8, %16, %18\n\tv_cmp_ge_u32_e64 %9, %17, %18\n\t"
                                     "v_addc_co_u32_e64 %0, %2, %0, 0, %2\n\tv_addc_co_u32_e64 %1, %3, %1, 0, %3\n\tv_addc_co_u32_e64 %0, %4, %0, 0, %4\n\tv_addc_co_u32_e64 %1, %5, %1, 0, %5\n\t"
                                     "v_addc_co_u32_e64 %0, %6, %0, 0, %6\n\tv_addc_co_u32_e64 %1, %7, %1, 0, %7\n\tv_addc_co_u32_e64 %0, %8, %0, 0, %8\n\tv_addc_co_u32_e64 %1, %9, %1, 0, %9"
                                     : "+v"(ca), "+v"(cb), "=&s"(m0), "=&s"(m1), "=&s"(m2), "=&s"(m3), "=&s"(m4), "=&s"(m5), "=&s"(m6), "=&s"(m7)
                                     : "v"(kv[j][i]), "v"(kv[j][i + 1]), "v"(kv[j][i + 2]), "v"(kv[j][i + 3]), "v"(kv[j][i + 4]), "v"(kv[j][i + 5]), "v"(kv[j][i + 6]), "v"(kv[j][i + 7]), "v"(cand));
                    }
                    const int cnt = wave_sum_dpp((int)(ca + cb));
                    if (cnt >= 256) { lo_u = cand; c_lo = cnt; } else { hi_u = cand; c_hi = cnt; }
                }
                const int qrow = (32 * rd + 8 * j + wave_s) * 64;
#pragma unroll
                for (int i = 0; i < 32; ++i) if (i < nv) { const unsigned long long mm = __ballot(kv[j][i] >= lo_u);
                    if (lane == 0) { GTM[qrow + 2 * i] = (unsigned)mm; GTM[qrow + 2 * i + 1] = (unsigned)(mm >> 32); } }
            }
        }
        AT_BAR();
    }
    }
    const int lane = lane_id_here(), tid = wave_s * 64 + lane, n = lane & 31, h = lane >> 5;
    const float C2 = 0.125f * 1.4426950408889634f;
    bf16x8_t qfe[2]; float nsl16[2], m_run[2], l_run[2]; int tql[2]; f32x16_t O[2][2];
#pragma unroll
    for (int i = 0; i < 8; ++i) { const int e = tid + 512 * i, R = e >> 3, pc = e & 7;
        *(LAS u32x4*)(lds + AT_QL + R * AT_KROW + pc * 16) = *(const GAS u32x4*)(Pb + (size_t)(c * 64 + (R >> 3)) * PC + PC_Q + (R & 7) * 64 + pc * 8); }
#pragma unroll
    for (int rb = 0; rb < 2; ++rb) { const int R = 64 * wave_s + 32 * rb + n, tl = R >> 3, hd = R & 7; tql[rb] = tl;
        { int cq = c; asm volatile("" : "+s"(cq)); const float sl8 = exp2f((float)(2 - hd));
          const unsigned q0 = __float_as_uint(64.f * sl8) >> 16, q1 = __float_as_uint(sl8) >> 16, q2 = __float_as_uint(-64.f * sl8 * (float)cq) >> 16, q3 = __float_as_uint(-sl8 * (float)tl) >> 16;
          const u32x4 qe = {h == 0 ? (q0 | (q1 << 16)) : 0u, h == 0 ? (q2 | (q3 << 16)) : 0u, 0u, 0u}; qfe[rb] = __builtin_bit_cast(bf16x8_t, qe); nsl16[rb] = -2.f * sl8; }
        m_run[rb] = -1.0e30f; l_run[rb] = 0.f;
#pragma unroll
        for (int db = 0; db < 2; ++db)
#pragma unroll
            for (int r = 0; r < 16; ++r) O[rb][db][r] = 0.f; }
    const int skey = tid >> 3, sch = tid & 7;
    u32x4 stK, stV;
    { gcb16 kp = Pb + (size_t)skey * PC + PC_K + sch * 8; stK = *(const GAS u32x4*)kp; stV = *(const GAS u32x4*)(kp + 64); }
    *(LAS u32x4*)(lds + AT_KT + skey * AT_KROW + sch * 16) = stK; *(LAS u32x4*)(lds + AT_VT + skey * AT_VROW + sch * 16) = stV;
    AT_BAR();
    const int gl = lane >> 4, i16 = lane & 15, trq = i16 >> 2, trp = i16 & 3;
    bf16x8_t qf[2][4];
#pragma unroll
    for (int rb = 0; rb < 2; ++rb)
#pragma unroll
        for (int s = 0; s < 4; ++s) qf[rb][s] = *(const LAS bf16x8_t*)(lds + AT_QL + (64 * wave_s + 32 * rb + n) * AT_KROW + (16 * s + 8 * h) * 2);
    for (int jt = 0; jt <= c; ++jt) {
        const int buf = jt & 1;
        if (jt < c) { gcb16 kp = Pb + (size_t)((jt + 1) * 64 + skey) * PC + PC_K + sch * 8; stK = *(const GAS u32x4*)kp; stV = *(const GAS u32x4*)(kp + 64); }
        const LAS unsigned char* KT = lds + AT_KT + buf * 64 * AT_KROW; const LAS unsigned char* VT = lds + AT_VT + buf * 64 * AT_VROW;
#pragma unroll 1
        for (int kb2 = 0; kb2 < 2; ++kb2) {
            bf16x8_t kf[4], vf[2][2];
            const u32x4 ke = {h == 0 ? ((__float_as_uint((float)jt) >> 16) | (__float_as_uint((float)(32 * kb2 + n)) & 0xffff0000u)) : 0u, h == 0 ? 0x3f803f80u : 0u, 0u, 0u};
            const bf16x8_t kfe = __builtin_bit_cast(bf16x8_t, ke);
#pragma unroll
            for (int s = 0; s < 4; ++s) kf[s] = *(const LAS bf16x8_t*)(KT + (32 * kb2 + n) * AT_KROW + (16 * s + 8 * h) * 2);
#pragma unroll
            for (int db = 0; db < 2; ++db)
#pragma unroll
                for (int s2 = 0; s2 < 2; ++s2) { const LAS unsigned char* vb = VT + (32 * kb2 + 16 * s2 + 4 * h + trq) * AT_VROW + (32 * db + 16 * (gl & 1) + 4 * trp) * 2;
                    const s16x4_t lo = tr_read(vb), hi = tr_read(vb + 8 * AT_VROW);
                    vf[db][s2] = (bf16x8_t){lo[0], lo[1], lo[2], lo[3], hi[0], hi[1], hi[2], hi[3]}; }
            f32x16_t sacc[2]; float sv[2][16], mt[2];
#pragma unroll
            for (int rb = 0; rb < 2; ++rb)
#pragma unroll
                for (int r = 0; r < 16; ++r) sacc[rb][r] = 0.f;
#pragma unroll
            for (int s = 0; s < 4; ++s)
#pragma unroll
                for (int rb = 0; rb < 2; ++rb) sacc[rb] = MFMA32(kf[s], qf[rb][s], sacc[rb]);
#pragma unroll
            for (int rb = 0; rb < 2; ++rb) sacc[rb] = MFMA32(kfe, qfe[rb], sacc[rb]);
            if (jt == c) {
#pragma unroll
                for (int rb = 0; rb < 2; ++rb) { const float fd = (float)(32 * kb2 + 4 * h - tql[rb]);
#pragma unroll
                    for (int r = 0; r < 16; ++r) sacc[rb][r] += nsl16[rb] * fmaxf(fd + (float)((r & 3) + 8 * (r >> 2)), 0.f); } }
#pragma unroll
            for (int rb = 0; rb < 2; ++rb) { const unsigned mw = GTM[tql[rb] * 64 + 2 * jt + kb2] >> (4 * h); float m_ = -INFINITY;
#pragma unroll
                for (int r = 0; r < 16; ++r) { const int sh = (r & 3) + 8 * (r >> 2);
                    const int tmask = __builtin_amdgcn_sbfe((int)mw, sh, 1);
                    sv[rb][r] = __uint_as_float((__float_as_uint(sacc[rb][r]) & (unsigned)tmask) | (0xff800000u & ~(unsigned)tmask)); m_ = fmaxf(m_, sv[rb][r]); }
                mt[rb] = swap32_max(m_) * C2; }
            if (__any((mt[0] > m_run[0] + 8.0f) | (mt[1] > m_run[1] + 8.0f))) {
#pragma unroll
                for (int rb = 0; rb < 2; ++rb) { const float mn = fmaxf(m_run[rb], mt[rb]), al = __builtin_amdgcn_exp2f(m_run[rb] - mn); m_run[rb] = mn; l_run[rb] *= al;
#pragma unroll
                    for (int db = 0; db < 2; ++db)
#pragma unroll
                        for (int r = 0; r < 16; ++r) O[rb][db][r] *= al; } }
#pragma unroll
            for (int rb = 0; rb < 2; ++rb) {
                float ps = 0.f; unsigned pw[8]; const float nm = -m_run[rb];
#pragma unroll
                for (int r = 0; r < 16; r += 2) { const float p0 = __builtin_amdgcn_exp2f(fmaf(sv[rb][r], C2, nm)), p1 = __builtin_amdgcn_exp2f(fmaf(sv[rb][r + 1], C2, nm)); ps += p0 + p1; pw[r >> 1] = cvtpk(p0, p1); }
                l_run[rb] += ps;
#pragma unroll
                for (int s2 = 0; s2 < 2; ++s2) { const u32x4 pk = {pw[4 * s2], pw[4 * s2 + 1], pw[4 * s2 + 2], pw[4 * s2 + 3]}; const bf16x8_t pf = __builtin_bit_cast(bf16x8_t, pk);
#pragma unroll
                    for (int db = 0; db < 2; ++db) O[rb][db] = MFMA32(vf[db][s2], pf, O[rb][db]); }
            }
        }
        if (jt < c) { const int nb_ = buf ^ 1; *(LAS u32x4*)(lds + AT_KT + nb_ * 64 * AT_KROW + skey * AT_KROW + sch * 16) = stK; *(LAS u32x4*)(lds + AT_VT + nb_ * 64 * AT_VROW + skey * AT_VROW + sch * 16) = stV; }
        AT_BAR();
    }
#pragma unroll
    for (int rb = 0; rb < 2; ++rb) { const float inv = 1.0f / swap32_addf(l_run[rb]); const int R = 64 * wave_s + 32 * rb + n, tl = R >> 3, hd = R & 7;
        gb16 op = AO + (size_t)(b * S + c * 64 + tl) * 512 + hd * 64 + 4 * h;
#pragma unroll
        for (int db = 0; db < 2; ++db)
#pragma unroll
            for (int g4 = 0; g4 < 4; ++g4) { u32x2v w; w.x = cvtpk(O[rb][db][4 * g4] * inv, O[rb][db][4 * g4 + 1] * inv); w.y = cvtpk(O[rb][db][4 * g4 + 2] * inv, O[rb][db][4 * g4 + 3] * inv);
                *(GAS u32x2v*)(op + 32 * db + 8 * g4) = w; } }
}


struct SrcId { __device__ int operator()(int r) const { return r; } };
struct SrcWin { __device__ int operator()(int r) const { return refcol_of(r); } };
template <int HALFN> struct SrcPair { __device__ int operator()(int r) const { const int t = r >> 8, i = r & 255; return i < 128 ? 128 * t + i : HALFN + 128 * t + (i - 128); } };
template <class SC>
__device__ __forceinline__ void transpose_item(gcf32 W, int K, int N, gb16 WT, SC sc, LAS float* scr  , int item, int lane) {
    const int nk = K / 64, kb = item % nk, nb = item / nk, k0 = 64 * kb, n0 = 64 * nb;
    const int c4 = 4 * (lane & 15), col = sc(n0 + c4);
    f32x4 tv[16];
#pragma unroll
    for (int i = 0; i < 16; ++i) { const int kk = 4 * i + (lane >> 4); tv[i] = (f32x4){0.f, 0.f, 0.f, 0.f}; if (col >= 0) tv[i] = *(const GAS f32x4*)(W + (size_t)(k0 + kk) * N + col); }
#pragma unroll
    for (int i = 0; i < 16; ++i) { const int kk = 4 * i + (lane >> 4); LAS float* d = scr + kk * 65 + c4; d[0] = tv[i][0]; d[1] = tv[i][1]; d[2] = tv[i][2]; d[3] = tv[i][3]; }
    asm volatile("s_waitcnt lgkmcnt(0)" ::: "memory");
    const int c = lane & 7;
#pragma unroll
    for (int j = 0; j < 8; ++j) { const int n = (lane >> 3) + 8 * j; const LAS float* s = scr + (8 * c) * 65 + n;
        u32x4 o; o.x = pg8::cvt_pk_bf16(s[0 * 65], s[1 * 65]); o.y = pg8::cvt_pk_bf16(s[2 * 65], s[3 * 65]); o.z = pg8::cvt_pk_bf16(s[4 * 65], s[5 * 65]); o.w = pg8::cvt_pk_bf16(s[6 * 65], s[7 * 65]);
        *(GAS u32x4*)(WT + (size_t)(n0 + n) * K + k0 + 8 * c) = o; }
    asm volatile("s_waitcnt lgkmcnt(0)" ::: "memory");
}
template <int I> __device__ __forceinline__ gcf32 KIN();
__device__ __forceinline__ void ph_weights(gu8 ws, LAS float* scr, int gw, int lane) {
    constexpr int I_WIN = 16 * (PC / 64), I_WFI = 16 * (2 * DFF / 64), I_WFO = (DFF / 64) * (D / 64), I_WO = 16 * (D / 64), I_WC = 4 * (D / 64), I_WGLU = 4 * (2 * D / 64), I_WAO = 8 * (D / 64);
    constexpr int I_WMOD = 16 * (6 * D / 64), I_LAYER = I_WMOD + I_WIN + I_WFI + I_WFO + I_WO + I_WC + I_WGLU + I_WAO;
    for (int it = gw; it < NL * I_LAYER; it += NGW) {
        const int l = it / I_LAYER; int r = it % I_LAYER; gu8 wl = ws + WS_W + (size_t)l * WS_W_LAYER;
        if (r < I_WMOD) { transpose_item(KIN<2>() + (size_t)l * D * 6 * D, D, 6 * D, (gb16)(ws + WS_WMODT) + (size_t)l * 6 * D * D, SrcId{}, scr, r, lane); continue; } r -= I_WMOD;
        if (r < I_WIN) { transpose_item(KIN<5>() + (size_t)l * D * DIN, D, DIN, (gb16)(wl + WO_WIN), SrcWin{}, scr, r, lane); continue; } r -= I_WIN;
        if (r < I_WFI) { transpose_item(KIN<21>() + (size_t)l * D * 2 * DFF, D, 2 * DFF, (gb16)(wl + WO_WFI), SrcPair<DFF>{}, scr, r, lane); continue; } r -= I_WFI;
        if (r < I_WFO) { transpose_item(KIN<22>() + (size_t)l * DFF * D, DFF, D, (gb16)(wl + WO_WFO), SrcId{}, scr, r, lane); continue; } r -= I_WFO;
        if (r < I_WO) { transpose_item(KIN<19>() + (size_t)l * D * D, D, D, (gb16)(wl + WO_WO), SrcId{}, scr, r, lane); continue; } r -= I_WO;
        if (r < I_WC) { transpose_item(KIN<8>() + (size_t)l * 256 * D, 256, D, (gb16)(wl + WO_WC), SrcId{}, scr, r, lane); continue; } r -= I_WC;
        if (r < I_WGLU) { transpose_item(KIN<17>() + (size_t)l * 256 * 2 * D, 256, 2 * D, (gb16)(wl + WO_WGLU), SrcPair<D>{}, scr, r, lane); continue; } r -= I_WGLU;
        transpose_item(KIN<18>() + (size_t)l * 512 * D, 512, D, (gb16)(wl + WO_WAO), SrcId{}, scr, r, lane);
    }
}
template <class Epi>
__device__ __forceinline__ void run_gemm(LAS unsigned char* ring, gcb16 A, int lda, gcb16 Bt, int N, int K, const Epi& E, int wave_s) {
    pg8::Gemm g{(const bf16_t*)A, (const bf16_t*)Bt, M, N, K, lda}; const int bx_ = (int)blockIdx.x; __builtin_assume(bx_ >= 0 && bx_ < GRID); pg8::StaticOrder S; S.init(M, N, GRID, bx_);
    pg8::gemm_phase<Epi, pg8::StaticOrder, true, true>(ring, g, S, E, wave_s);
}
struct PairedOrder : pg8::StaticOrder {
    __device__ __forceinline__ bool next(int j, Unit& u) const { Unit v; if (!pg8::StaticOrder::next(j >> 1, v)) return false; u.pm = v.pm; u.pn = 2 * v.pn + (j & 1); return true; }
};
template <class Epi>
__device__ __forceinline__ void run_gemm_paired(LAS unsigned char* ring, gcb16 A, int lda, gcb16 Bt, int K, const Epi& E, int wave_s) {
    pg8::Gemm g{(const bf16_t*)A, (const bf16_t*)Bt, M, 2 * D, K, lda}; const int bx_ = (int)blockIdx.x; __builtin_assume(bx_ >= 0 && bx_ < GRID); PairedOrder S; S.init(M, D, GRID, bx_);
    pg8::gemm_phase<Epi, PairedOrder, true, true>(ring, g, S, E, wave_s);
}
template <class Epi>
__device__ __forceinline__ void run_gemm16(LAS unsigned char* ring, gcb16 A, gcb16 Bt, int N, const Epi& E, int cidx, int wave_s) {
    if (cidx < 0 || cidx >= N / 256) return;
    pg8::Gemm g{(const bf16_t*)A, (const bf16_t*)Bt, 256, N, D, D}; pg8::StaticOrder S; S.init(256, N, GRID, cidx);
    pg8::gemm_phase<Epi, pg8::StaticOrder, true, true>(ring, g, S, E, wave_s);
}

template <int I> __device__ __forceinline__ gcf32 KIN() {
    auto kp = __builtin_amdgcn_kernarg_segment_ptr(); unsigned long long v;
    asm volatile("s_load_dwordx2 %0, %1, %2\n\ts_waitcnt lgkmcnt(0)" : "=s"(v) : "s"(kp), "i"(8 * I) : "memory");
    return (gcf32)v;
}
__global__ void __launch_bounds__(NTHREADS, 2) mk_fwd(Args a) {
    extern __shared__ __attribute__((aligned(16))) unsigned char lds_raw[];
    LAS unsigned char* ring = (LAS unsigned char*)lds_raw;
    volatile LAS unsigned* MISC = (volatile LAS unsigned*)((LAS unsigned char*)lds_raw + MISC_OFF);
    const int wave_s = __builtin_amdgcn_readfirstlane(threadIdx.x >> 6);
    { const unsigned bx_ = blockIdx.x; __builtin_assume(bx_ < GRID); } __builtin_assume(wave_s >= 0 && wave_s < NWAVES);
#define IDS const int lane = lane_id_here(), gw = blockIdx.x * NWAVES + wave_s; __builtin_assume(gw >= 0 && gw < NGW); __builtin_assume(lane >= 0 && lane < 64); (void)lane; (void)gw;
    if (wave_s == 0) { const int l0 = lane_id_here(); if (l0 < 32) MISC[l0] = 0u; }
    __syncthreads();
    gu8 ws = (gu8)KIN<25>();
    XcdBarrier bar = xcd_barrier_post((unsigned*)(ws + WS_CTL) + 1024, MISC + 8, wave_s, GRID);
#define XB_ ((gb16)KIN<24>())
#define X_ ((gf32)(ws + WS_P + 176 * MiB))
#define MOD_ ((gf32)(ws + WS_MOD))
#define H_ ((gb16)(ws + WS_H))
#define CONVA_ ((gb16)(ws + WS_CONVA))
#define Z_ ((gb16)(ws + WS_Z))
#define AO_ ((gb16)(ws + WS_AO))
#define P_ ((gb16)(ws + WS_P))
#define ACT_ ((gb16)(ws + WS_P))
#define WT_(l, off) ((gcb16)(ws + WS_W + (size_t)(l) * WS_W_LAYER + (off)))
#define A16_(i) ((gb16)(ws + WS_A16) + (size_t)(i) * 256 * D)
    { IDS; ph_a16(KIN<1>(), A16_(0), (gu64)(ws + WS_SSQ), gw, lane); }
    { IDS; ph_ssm_params(KIN<9>(), KIN<10>(), KIN<11>(), KIN<12>(), KIN<13>(), (gf32)(ws + WS_SSMP), (gf32)(ws + WS_AP), gw, lane); }
    { IDS; ph_ssm_kd(KIN<9>(), KIN<10>(), KIN<11>(), KIN<12>(), KIN<13>(), KIN<14>(), KIN<15>(), (gf32)(ws + WS_KD), (LAS float*)(ring + wave_s * 16640), gw, lane); }
    { IDS; ph_weights(ws, (LAS float*)(ring + wave_s * 16640), gw, lane); }
    xcd_barrier(bar, wave_s);
    { const int bxv = (int)blockIdx.x;
      for (int l = 0; l < NL; ++l) run_gemm16(ring, A16_(0), (gcb16)(ws + WS_WMODT) + (size_t)l * 6 * D * D, 6 * D, EpiMod{MOD_ + (size_t)l * NB * 6 * D, KIN<3>() + l * 6 * D, A16_(1 + 2 * l), A16_(2 + 2 * l)}, bxv - 128 * l, wave_s); }
    { IDS; ph_ssm_frags(KIN<14>(), KIN<15>(), (gcf32)(ws + WS_SSMP), (gcf32)(ws + WS_AP), (gcf32)(ws + WS_KD), ws + WS_SSMT, gw, lane); }
    xcd_barrier(bar, wave_s);
    { const int bxv = (int)blockIdx.x;
      for (int l = 0; l < NL; ++l) {
          run_gemm16(ring, A16_(1 + 2 * l), WT_(l, WO_WIN), PC, EpiBias{(gf32)(ws + WS_BIAS) + (size_t)l * BIAS_LAYER, PC, KIN<6>() + l * 3 * D, PC_G}, bxv - 128 * l, wave_s);
          run_gemm16(ring, A16_(2 + 2 * l), WT_(l, WO_WFI), 2 * DFF, EpiBias{(gf32)(ws + WS_BIAS) + (size_t)l * BIAS_LAYER + NB * PC, 2 * DFF, (gcf32)nullptr, 0}, bxv - 128 * l - 64, wave_s); } }
    { const int bxv = (int)blockIdx.x, q4 = bxv >> 6, r64 = bxv & 63, ng = (q4 & 1) ? 22 : 20;
      if (r64 >= ng) { const int rank = q4 * 64 - (q4 >> 1) * 42 - (q4 & 1) * 20 + (r64 - ng); const int lane = lane_id_here(); ph_h0(KIN<0>(), KIN<4>(), MOD_, D, H_, (gu64)(ws + WS_SSQ), rank * NWAVES + wave_s, 172 * NWAVES, lane); } }
    xcd_barrier(bar, wave_s);
#define SSQ_(i) ((gu64)(ws + WS_SSQ) + (size_t)(i) * M)
#define MODL_(l) (MOD_ + (size_t)(l) * NB * 6 * D)
#define BIAS_(l) ((gcf32)(ws + WS_BIAS) + (size_t)(l) * BIAS_LAYER)
    const int grp_ = (int)blockIdx.x & 7;
#define CONVAv ((gb16)(ws + WS_H + (size_t)grp_ * 6 * MiB))
#define Zv ((gb16)(ws + WS_H + 2 * MiB + (size_t)grp_ * 6 * MiB))
#define AOv ((gb16)(ws + WS_H + 4 * MiB + (size_t)grp_ * 4 * MiB))
#define ACTv ((gb16)(ws + WS_P + (size_t)grp_ * 18 * MiB))
#define Xv ((gf32)(ws + WS_P + 22 * MiB + (size_t)grp_ * 24 * MiB))
#define XBv ((gb16)KIN<24>() + (size_t)grp_ * 4 * 1024 * 1024)
    XcdBarrier gbar = xcd_barrier_post((unsigned*)(ws + WS_GBAR + (size_t)grp_ * 16384), MISC + 10, wave_s, GRID / 8);
    for (int l = 0; l < NL; ++l) {
        run_gemm(ring, H_, D, WT_(l, WO_WIN), PC, D, EpiInproj{P_, BIAS_(l), SSQ_(2 * l)}, wave_s);
        xcd_barrier(gbar, wave_s);
        { const int v = (blockIdx.x & 7) * 32 + (blockIdx.x >> 3);
          { const int lane = lane_id_here(); ph_conv(P_, KIN<7>() + l * 768, CONVAv, v * NWAVES + wave_s, lane); }
          ssm_fast_item(ring, P_, ws + WS_SSMT + (size_t)l * SSMT_LAYER, (gcf32)(ws + WS_AP) + (size_t)l * 1024 * 65 * 2, KIN<16>() + l * 256, Zv, v >> 4, v & 15, wave_s);
          attn_unit(ring, P_, AOv, v >> 4, 31 - (v & 15), wave_s); attn_unit(ring, P_, AOv, v >> 4, v & 15, wave_s); }
        xcd_barrier(gbar, wave_s);
        run_gemm_paired(ring, Zv, 256, WT_(l, WO_WGLU), 256, EpiGlu{P_}, wave_s);
        run_gemm(ring, CONVAv, 256, WT_(l, WO_WC), D, 256, EpiMixAcc{P_, PC_G}, wave_s);
        run_gemm(ring, AOv, 512, WT_(l, WO_WAO), D, 512, EpiMixAcc{P_, PC_G + 2 * D}, wave_s);
        xcd_barrier(gbar, wave_s);
        run_gemm(ring, P_, PC, WT_(l, WO_WO), D, D, EpiRes{(l == 0) ? KIN<0>() : (gcf32)nullptr, (l == 0) ? (gcb16)nullptr : (gcb16)XBv, (gf32)nullptr, XBv, MODL_(l) + 2 * D, SSQ_(2 * l + 1), H_, KIN<20>() + l * D, MODL_(l) + 4 * D}, wave_s);
        xcd_barrier(gbar, wave_s);
        run_gemm(ring, H_, D, WT_(l, WO_WFI), 2 * DFF, D, EpiFfnIn{ACTv, BIAS_(l) + NB * PC, SSQ_(2 * l + 1)}, wave_s);
        xcd_barrier(gbar, wave_s);
        run_gemm(ring, ACTv, DFF, WT_(l, WO_WFO), D, DFF, EpiRes{(gcf32)nullptr, XBv, (l + 1 < NL) ? (gf32)nullptr : Xv, (l + 1 < NL) ? XBv : (gb16)nullptr, MODL_(l) + 5 * D, SSQ_(2 * l + 2), (l + 1 < NL) ? H_ : (gb16)nullptr, KIN<4>() + (l + 1 < NL ? (l + 1) * D : 0), MODL_(l + 1 < NL ? l + 1 : l) + D}, wave_s);
        xcd_barrier(gbar, wave_s);
    }
    { const int lane = lane_id_here(); ph_final_norm(Xv, (gf32)KIN<24>(), KIN<23>(), SSQ_(2 * NL), grp_ * (M / 8), M / 8, ((int)blockIdx.x >> 3) * NWAVES + wave_s, (GRID / 8) * NWAVES, lane); }
}
}

extern "C" void kernel_launch(void* const* d_in, const int* in_sizes, int n_in, void* d_out, int out_size, void* d_ws, size_t ws_size, hipStream_t stream) {
    static int ok = 0;
    if (ok == 0) {
        int dev = 0, cus = 0;
        if (n_in != 24 || ws_size < WS_END || hipGetDevice(&dev) != hipSuccess || hipDeviceGetAttribute(&cus, hipDeviceAttributeMultiprocessorCount, dev) != hipSuccess || cus != GRID) {
            fprintf(stderr, "kernel_launch: unexpected configuration (n_in %d, ws %zu, CUs %d)\n", n_in, ws_size, cus); ok = -1; return; }
        if (hipFuncSetAttribute((const void*)mk_fwd, hipFuncAttributeMaxDynamicSharedMemorySize, LDS_BYTES) != hipSuccess) { fprintf(stderr, "kernel_launch: hipFuncSetAttribute failed\n"); ok = -1; return; }
        ok = 1;
    }
    if (ok < 0) return;
    (void)hipMemsetAsync((char*)d_ws + WS_CTL, 0, CTL_ZERO_BYTES, stream);
    Args a{};
    for (int i = 0; i < 24; ++i) a.in[i] = (const float*)d_in[i];
    a.out = (float*)d_out; a.ws = (unsigned char*)d_ws;
    hipLaunchKernelGGL(mk_fwd, dim3(GRID), dim3(NTHREADS), LDS_BYTES, stream, a);
}
```
